# Optimizing an MI355X kernel written in HIP

```python
import numpy as np
import jax, jax.numpy as jnp
from jax import lax

D_MODEL = 1024
BATCH = 8
SEQ = 2048
DEPTH = 4

CHUNK = 64
Q_BLOCK = 128
EPS = 1e-6
NEG_INF = -1e30

A_HEADS = 8
A_HEAD_DIM = 64
B_HEADS = 8
B_NOPE = 64
B_ROPE = 32
B_V = 64
B_Q_LORA = 384
B_KV_LORA = 256
ROPE_THETA = 10000.0
C_HEADS = 8
C_HEAD_DIM = 64
C_LEFT_CHUNKS = 8
C_BAND = (C_LEFT_CHUNKS + 1) * CHUNK
REL_CLIP = 256
N_BRANCH = 3
BRANCH_WIDTH = 512
D_FF = 4 * D_MODEL

A_W = A_HEADS * A_HEAD_DIM
C_W = C_HEADS * C_HEAD_DIM
B_QUP = B_HEADS * (B_NOPE + B_ROPE)
B_KVUP = B_HEADS * (B_NOPE + B_V)
IN_SIZES = (A_W, A_W, A_W, A_HEADS, B_Q_LORA, B_KV_LORA, B_ROPE, C_W, C_W, C_W, N_BRANCH * D_MODEL)
IN_WIDTH = sum(IN_SIZES)

kernel_name = "hybrid_fox_mla_chunkrel_gated_encoder"


def rms_norm(x, g):
    xf = x.astype(jnp.float32)
    y = xf * lax.rsqrt(jnp.mean(xf * xf, axis=-1, keepdims=True) + EPS)
    return (y * g.astype(jnp.float32)).astype(x.dtype)


def rope(x, pos):
    half = B_ROPE // 2
    inv = ROPE_THETA ** (-jnp.arange(half, dtype=jnp.float32) / half)
    ang = pos.astype(jnp.float32)[:, None] * inv[None, :]
    cos = jnp.cos(ang)[:, None, :]
    sin = jnp.sin(ang)[:, None, :]
    xf = x.astype(jnp.float32)
    x1, x2 = xf[..., :half], xf[..., half:]
    return jnp.concatenate([x1 * cos - x2 * sin, x2 * cos + x1 * sin], axis=-1).astype(x.dtype)


def prefix_block_attention(q, k, v, frame_causal, cum_logf=None):
    S = q.shape[1]
    scale = q.shape[-1] ** -0.5
    outs = []
    for i in range(S // Q_BLOCK):
        q0, q1 = i * Q_BLOCK, (i + 1) * Q_BLOCK
        s = jnp.einsum('bqhd,bkhd->bhqk', q[:, q0:q1], k[:, :q1],
                       preferred_element_type=jnp.float32) * scale
        qpos = jnp.arange(q0, q1)[:, None]
        kpos = jnp.arange(q1)[None, :]
        if frame_causal:
            mask = kpos <= qpos
        else:
            mask = (kpos // CHUNK) <= (qpos // CHUNK)
        if cum_logf is not None:
            s = s + (cum_logf[:, :, q0:q1, None] - cum_logf[:, :, None, :q1])
        p = jax.nn.softmax(jnp.where(mask, s, NEG_INF), axis=-1)
        outs.append(jnp.einsum('bhqk,bkhd->bqhd', p.astype(v.dtype), v[:, :q1]))
    return jnp.concatenate(outs, axis=1)


def chunk_band_attention(q, k, v, rel_bias):
    B, S, H, D = q.shape
    NC = S // CHUNK
    qc = q.reshape(B, NC, CHUNK, H, D)

    def band(t):
        tc = t.reshape(B, NC, CHUNK, H, D)
        tp = jnp.pad(tc, ((0, 0), (C_LEFT_CHUNKS, 0), (0, 0), (0, 0), (0, 0)))
        return jnp.concatenate([tp[:, j:j + NC] for j in range(C_LEFT_CHUNKS + 1)], axis=2)

    kb, vb = band(k), band(v)
    s = jnp.einsum('bnqhd,bnkhd->bhnqk', qc, kb, preferred_element_type=jnp.float32) * (D ** -0.5)
    qpos = jnp.arange(CHUNK)[:, None]
    kpos = jnp.arange(C_BAND)[None, :] - C_LEFT_CHUNKS * CHUNK
    rel = jnp.clip(qpos - kpos, -REL_CLIP, REL_CLIP) + REL_CLIP
    bias = rel_bias.astype(jnp.float32)[:, rel]
    valid = (jnp.arange(NC)[:, None] - C_LEFT_CHUNKS + jnp.arange(C_BAND)[None, :] // CHUNK) >= 0
    s = jnp.where(valid[None, None, :, None, :], s + bias[None, :, None], NEG_INF)
    p = jax.nn.softmax(s, axis=-1)
    o = jnp.einsum('bhnqk,bnkhd->bnqhd', p.astype(v.dtype), vb)
    return o.reshape(B, S, H, D)


def setup_inputs(seed: int = 0) -> dict:
    key = jax.random.key(seed)
    ks = jax.random.split(key, 20)
    f32 = jnp.float32

    def nrm(k, shape, fan_in, gain=1.0):
        return jax.random.normal(k, shape, f32) * (gain * fan_in ** -0.5)

    def gain(k, shape):
        return 1.0 + 0.02 * jax.random.normal(k, shape, f32)

    res = (2 * DEPTH) ** -0.5
    return {
        "x": jax.random.normal(ks[0], (BATCH, SEQ, D_MODEL), f32),
        "norm_mix": gain(ks[1], (DEPTH, D_MODEL)),
        "w_in": nrm(ks[2], (DEPTH, D_MODEL, IN_WIDTH), D_MODEL),
        "b_forget": jax.random.uniform(ks[3], (DEPTH, A_HEADS), f32, 1.0, 4.0),
        "b_gate": 0.1 * jax.random.normal(ks[4], (DEPTH, N_BRANCH * D_MODEL), f32),
        "qk_norm_a": gain(ks[5], (DEPTH, 2, A_HEAD_DIM)),
        "mla_q_norm": gain(ks[6], (DEPTH, B_Q_LORA)),
        "mla_kv_norm": gain(ks[7], (DEPTH, B_KV_LORA)),
        "w_q_up": nrm(ks[8], (DEPTH, B_Q_LORA, B_QUP), B_Q_LORA),
        "w_kv_up": nrm(ks[9], (DEPTH, B_KV_LORA, B_KVUP), B_KV_LORA),
        "qk_norm_b_nope": gain(ks[10], (DEPTH, 2, B_NOPE)),
        "qk_norm_b_rope": gain(ks[11], (DEPTH, 2, B_ROPE)),
        "qk_norm_c": gain(ks[12], (DEPTH, 2, C_HEAD_DIM)),
        "rel_bias": 0.1 * jax.random.normal(ks[13], (DEPTH, C_HEADS, 2 * REL_CLIP + 1), f32),
        "w_branch": nrm(ks[14], (DEPTH, N_BRANCH, BRANCH_WIDTH, D_MODEL), BRANCH_WIDTH),
        "w_out": nrm(ks[15], (DEPTH, D_MODEL, D_MODEL), D_MODEL, res),
        "norm_ffn": gain(ks[16], (DEPTH, D_MODEL)),
        "w_ff1": nrm(ks[17], (DEPTH, D_MODEL, D_FF), D_MODEL),
        "w_ff2": nrm(ks[18], (DEPTH, D_FF, D_MODEL), D_FF, res),
    }


def reference(x, norm_mix, w_in, b_forget, b_gate, qk_norm_a, mla_q_norm, mla_kv_norm,
              w_q_up, w_kv_up, qk_norm_b_nope, qk_norm_b_rope, qk_norm_c, rel_bias,
              w_branch, w_out, norm_ffn, w_ff1, w_ff2):
    B, S, _ = x.shape
    pos = jnp.arange(S)
    split_at = tuple(int(i) for i in np.cumsum(IN_SIZES)[:-1])
    for l in range(DEPTH):
        h = rms_norm(x, norm_mix[l])
        u = h @ w_in[l]
        (qa, ka, va, fa, qd, kvd, kr, qc, kc, vc, gl) = jnp.split(u, split_at, axis=-1)

        qa = rms_norm(qa.reshape(B, S, A_HEADS, A_HEAD_DIM), qk_norm_a[l, 0])
        ka = rms_norm(ka.reshape(B, S, A_HEADS, A_HEAD_DIM), qk_norm_a[l, 1])
        va = va.reshape(B, S, A_HEADS, A_HEAD_DIM)
        log_f = jax.nn.log_sigmoid(fa.astype(jnp.float32) + b_forget[l].astype(jnp.float32))
        cum_logf = jnp.cumsum(log_f, axis=1).transpose(0, 2, 1)
        ya = prefix_block_attention(qa, ka, va, True, cum_logf).reshape(B, S, BRANCH_WIDTH)

        qb = (rms_norm(qd, mla_q_norm[l]) @ w_q_up[l]).reshape(B, S, B_HEADS, B_NOPE + B_ROPE)
        kvb = (rms_norm(kvd, mla_kv_norm[l]) @ w_kv_up[l]).reshape(B, S, B_HEADS, B_NOPE + B_V)
        q_nope = rms_norm(qb[..., :B_NOPE], qk_norm_b_nope[l, 0])
        q_rope = rope(rms_norm(qb[..., B_NOPE:], qk_norm_b_rope[l, 0]), pos)
        k_nope = rms_norm(kvb[..., :B_NOPE], qk_norm_b_nope[l, 1])
        vb = kvb[..., B_NOPE:]
        k_rope = rope(rms_norm(kr.reshape(B, S, 1, B_ROPE), qk_norm_b_rope[l, 1]), pos)
        k_rope = jnp.broadcast_to(k_rope, (B, S, B_HEADS, B_ROPE))
        q_mla = jnp.concatenate([q_nope, q_rope], axis=-1)
        k_mla = jnp.concatenate([k_nope, k_rope], axis=-1)
        yb = prefix_block_attention(q_mla, k_mla, vb, False).reshape(B, S, BRANCH_WIDTH)

        qc = rms_norm(qc.reshape(B, S, C_HEADS, C_HEAD_DIM), qk_norm_c[l, 0])
        kc = rms_norm(kc.reshape(B, S, C_HEADS, C_HEAD_DIM), qk_norm_c[l, 1])
        vc = vc.reshape(B, S, C_HEADS, C_HEAD_DIM)
        yc = chunk_band_attention(qc, kc, vc, rel_bias[l]).reshape(B, S, BRANCH_WIDTH)

        y = jnp.stack([ya, yb, yc], axis=2)
        proj = jnp.einsum('bsnc,ncd->bsnd', y, w_branch[l])
        gates = jax.nn.sigmoid(gl + b_gate[l]).reshape(B, S, N_BRANCH, D_MODEL)
        merged = jnp.sum(gates * proj, axis=2)
        x = x + merged @ w_out[l]

        h = rms_norm(x, norm_ffn[l])
        x = x + jnp.square(jax.nn.relu(h @ w_ff1[l])) @ w_ff2[l]
    return x
```

```cpp
#include <hip/hip_runtime.h>
#include <hip/hip_cooperative_groups.h>
#include <cstdio>
#include <cstdint>
namespace cg = cooperative_groups;
__device__ __forceinline__ int lane_id_v() { int l; asm volatile("v_mbcnt_lo_u32_b32 %0, -1, 0\n\tv_mbcnt_hi_u32_b32 %0, -1, %0" : "=v"(l)); return l; }
namespace pg8 {
#define PG8_LAS __attribute__((address_space(3)))
typedef unsigned short bf16_t;
typedef short bf16x8 __attribute__((ext_vector_type(8)));
typedef float f32x4 __attribute__((ext_vector_type(4)));
typedef unsigned u32x4 __attribute__((ext_vector_type(4)));
constexpr int BM = 256, BK = 64, HALF = 128, HTB = HALF * BK * 2, STAGE_BYTES = 8 * HTB, NXCD = 8, WGM = 8;

__host__ __device__ __forceinline__ int lds_byte(int r, int c) { const int st = (r >> 4) * 2 + (c >> 5), rr = r & 15, cc = c & 31, ob = rr * 64 + cc * 2; return st * 1024 + (ob ^ (((ob >> 9) & 1) << 5)); }
__host__ __device__ __forceinline__ void stage_rc(int b, int& R, int& C) { const int st = b / 1024, sb = b % 1024, swz = sb ^ (((sb >> 9) & 1) << 5); R = (st >> 1) * 16 + swz / 64; C = (st & 1) * 32 + (swz % 64) / 2; }
__host__ __device__ __forceinline__ int perm32(int rho) { const int n = rho >> 4, i = rho & 15; return 8 * (i >> 2) + 4 * n + (i & 3); }

struct Unit { int pm, pn, pz, ord; };
struct Gemm { const bf16_t* A; const bf16_t* Bt; int M, N, K; size_t azs, bzs; };

struct StaticOrder {
    int nM, nN, nwg, G, c, NZ;
    __host__ __device__ void init(int M, int N, int G_, int c_, int NZ_ = 1) { nM = M / BM; nN = N / BM; nwg = nM * nN; G = G_; c = c_; NZ = NZ_; }
    __host__ __device__ bool next(int i, Unit& u) const {
        const int t = i / NZ; u.pz = i - t * NZ; u.ord = i;
        const long L = (long)t * G + c; if (L >= nwg) return false;
        int wgid = (int)L; { const int q = nwg / NXCD, r = nwg % NXCD, xcd = wgid % NXCD, off = wgid / NXCD; wgid = (xcd < r ? xcd * (q + 1) : r * (q + 1) + (xcd - r) * q) + off; }
        const int nig = WGM * nN, gid = wgid / nig, fm = gid * WGM, gsz = (nM - fm) < WGM ? (nM - fm) : WGM;
        u.pm = fm + ((wgid % nig) % gsz); u.pn = (wgid % nig) / gsz; return true;
    }
};

template <class Epi, class Sched, bool ALIGN_EPI = false, bool SP2 = false>
__device__ __forceinline__ void gemm_phase(PG8_LAS unsigned char* lds, const Gemm g, const Sched& S, const Epi& E, int wave0) {
    int tid_ = wave0 * 64 + lane_id_v(); asm volatile("" : "+v"(tid_));
    const int tid = tid_, wid = __builtin_amdgcn_readfirstlane(tid >> 6), lane = tid & 63, wr = wid >> 2, wc = wid & 3, fr = lane & 15, fq = lane >> 4;
    const int K = g.K, nt = K / BK;
    size_t zo = 0; asm volatile("" : "+s"(zo));
    const char* gA = (const char*)g.A + zo; const char* gB = (const char*)g.Bt + zo;
    unsigned voffA[2], voffB[2];
#pragma unroll
    for (int i = 0; i < 2; ++i) { int R, C; stage_rc(tid * 16 + i * 8192, R, C); const int Rb = Epi::PERM ? ((R & ~31) + perm32(R & 31)) : R;
        voffA[i] = (unsigned)(R * K + C) * 2u; voffB[i] = (unsigned)(Rb * K + C) * 2u; }
    const size_t kstep = (size_t)(BK * 2);
    const size_t hstep = (size_t)HALF * K * 2;
    const size_t tstep = 2 * hstep;
    const unsigned ldsw = (unsigned)wid * 1024u;
    const int aoff = lds_byte(wr * 64 + fr, fq * 8), boff = lds_byte(wc * 32 + fr, fq * 8);
#define PG8_SA(b, h) (((b) * 2 + (h)) * HTB)
#define PG8_SB(b, h) ((4 + (b) * 2 + (h)) * HTB)
#define PG8_STAGE(bufoff, gbase, voff) do { _Pragma("unroll") for (int _i = 0; _i < 2; ++_i) \
        __builtin_amdgcn_global_load_lds((const unsigned*)((const char*)(gbase) + (voff)[_i]), (PG8_LAS unsigned*)(lds + (bufoff) + ldsw + _i * 8192), 16, 0, 0); } while (0)
#define PG8_LDA(dst, b, h) do { _Pragma("unroll") for (int m = 0; m < 4; ++m) _Pragma("unroll") for (int k = 0; k < 2; ++k) dst[m][k] = *(const PG8_LAS bf16x8*)(lds + PG8_SA(b, h) + aoff + m * 2048 + k * 1024); } while (0)
#define PG8_LDB(dst, b, h) do { _Pragma("unroll") for (int n = 0; n < 2; ++n) _Pragma("unroll") for (int k = 0; k < 2; ++k) dst[n][k] = *(const PG8_LAS bf16x8*)(lds + PG8_SB(b, h) + boff + n * 2048 + k * 1024); } while (0)
#define PG8_MMA(ai, bj, At, Bt) do { __builtin_amdgcn_s_setprio(1); _Pragma("unroll") for (int m = 0; m < 4; ++m) _Pragma("unroll") for (int n = 0; n < 2; ++n) _Pragma("unroll") for (int k = 0; k < 2; ++k) \
        acc[ai][bj][m][n] = __builtin_amdgcn_mfma_f32_16x16x32_bf16(Bt[n][k], At[m][k], acc[ai][bj][m][n], 0, 0, 0); __builtin_amdgcn_s_setprio(0); } while (0)
#define PG8_WAIT_V(n) asm volatile("s_waitcnt vmcnt(" #n ")" ::: "memory")
#define PG8_WAIT_L(n) asm volatile("s_waitcnt lgkmcnt(" #n ")" ::: "memory")
#define PG8_BAR __builtin_amdgcn_s_barrier()
#define PG8_SCHED __builtin_amdgcn_sched_barrier(0)
    Unit cur, nxt; int ui = 0;
    if (!S.next(0, cur)) return;
    f32x4 acc[2][2][4][2];
    if constexpr (Epi::INIT) E.init(acc, cur, wr, wc, fr, fq);
    else
#pragma unroll
    for (int a = 0; a < 2; ++a)
#pragma unroll
        for (int b = 0; b < 2; ++b)
#pragma unroll
            for (int m = 0; m < 4; ++m)
#pragma unroll
                for (int n = 0; n < 2; ++n) acc[a][b][m][n] = (f32x4){0.f, 0.f, 0.f, 0.f};
    bf16x8 At[4][2], B0[2][2], B1[2][2];
    const char* cA = gA + (size_t)cur.pm * tstep + (size_t)cur.pz * g.azs; const char* cB = gB + (size_t)cur.pn * tstep + (size_t)cur.pz * g.bzs;
    if constexpr (SP2) {
        PG8_STAGE(PG8_SB(0, 0), cB, voffB); PG8_STAGE(PG8_SB(0, 1), cB + hstep, voffB); PG8_STAGE(PG8_SA(0, 0), cA, voffA); PG8_STAGE(PG8_SA(0, 1), cA + hstep, voffA);
        if (wr == 1) PG8_BAR;
        PG8_WAIT_V(2); PG8_BAR;
        PG8_STAGE(PG8_SB(1, 0), cB + kstep, voffB); PG8_STAGE(PG8_SA(1, 0), cA + kstep, voffA); PG8_STAGE(PG8_SB(1, 1), cB + hstep + kstep, voffB);
        PG8_WAIT_V(6); PG8_BAR;
    } else {
        PG8_STAGE(PG8_SB(0, 0), cB, voffB); PG8_STAGE(PG8_SA(0, 0), cA, voffA); PG8_STAGE(PG8_SB(0, 1), cB + hstep, voffB); PG8_STAGE(PG8_SA(0, 1), cA + hstep, voffA);
        if (wr == 1) PG8_BAR;
        PG8_WAIT_V(4); PG8_BAR;
        PG8_STAGE(PG8_SB(1, 0), cB + kstep, voffB); PG8_STAGE(PG8_SA(1, 0), cA + kstep, voffA); PG8_STAGE(PG8_SB(1, 1), cB + hstep + kstep, voffB);
        PG8_WAIT_V(6); PG8_BAR;
    }
    for (;;) {
        const bool has_next = S.next(ui + 1, nxt);
        const char* nA = has_next ? gA + (size_t)nxt.pm * tstep + (size_t)nxt.pz * g.azs : cA; const char* nB = has_next ? gB + (size_t)nxt.pn * tstep + (size_t)nxt.pz * g.bzs : cB;
        for (int t = 0; t < nt; t += 2) {
            const bool last = (t == nt - 2);
            const char* a1 = cA + (size_t)(t + 1) * kstep;
            const char* a2 = last ? nA : cA + (size_t)(t + 2) * kstep; const char* b2 = last ? nB : cB + (size_t)(t + 2) * kstep;
            const char* a3 = a2 + kstep; const char* b3 = b2 + kstep;
            if constexpr (SP2) {
            PG8_LDB(B0, 0, 0); PG8_LDB(B1, 0, 1); PG8_SCHED; PG8_LDA(At, 0, 0); PG8_STAGE(PG8_SA(1, 1), a1 + hstep, voffA);
            PG8_WAIT_V(8); PG8_WAIT_L(0); PG8_BAR; PG8_MMA(0, 0, At, B0); PG8_MMA(0, 1, At, B1); PG8_BAR; PG8_SCHED;
            PG8_LDA(At, 0, 1); PG8_STAGE(PG8_SB(0, 0), b2, voffB); PG8_STAGE(PG8_SB(0, 1), b2 + hstep, voffB); PG8_STAGE(PG8_SA(0, 0), a2, voffA);
            PG8_WAIT_V(8); PG8_WAIT_L(0); PG8_BAR; PG8_MMA(1, 0, At, B0); PG8_MMA(1, 1, At, B1); PG8_BAR; PG8_SCHED;
            PG8_LDB(B0, 1, 0); PG8_LDB(B1, 1, 1); PG8_SCHED; PG8_LDA(At, 1, 0); PG8_STAGE(PG8_SA(0, 1), a2 + hstep, voffA);
            PG8_WAIT_V(8); PG8_WAIT_L(0); PG8_BAR; PG8_MMA(0, 0, At, B0); PG8_MMA(0, 1, At, B1); PG8_BAR; PG8_SCHED;
            PG8_LDA(At, 1, 1); PG8_STAGE(PG8_SB(1, 0), b3, voffB); PG8_STAGE(PG8_SB(1, 1), b3 + hstep, voffB); PG8_STAGE(PG8_SA(1, 0), a3, voffA);
            PG8_WAIT_V(8); PG8_WAIT_L(0); PG8_BAR; PG8_MMA(1, 0, At, B0); PG8_MMA(1, 1, At, B1); PG8_BAR; PG8_SCHED;
            } else {
            PG8_LDB(B0, 0, 0); PG8_SCHED; PG8_LDA(At, 0, 0); PG8_STAGE(PG8_SA(1, 1), a1 + hstep, voffA);
            PG8_WAIT_L(8); PG8_BAR; PG8_WAIT_L(0); PG8_MMA(0, 0, At, B0); PG8_BAR; PG8_SCHED;
            PG8_LDB(B1, 0, 1); PG8_STAGE(PG8_SB(0, 0), b2, voffB);
            PG8_BAR; PG8_WAIT_L(0); PG8_MMA(0, 1, At, B1); PG8_BAR;
            PG8_LDA(At, 0, 1); PG8_STAGE(PG8_SA(0, 0), a2, voffA);
            PG8_BAR; PG8_WAIT_L(0); PG8_MMA(1, 0, At, B0); PG8_BAR; PG8_SCHED;
            PG8_STAGE(PG8_SB(0, 1), b2 + hstep, voffB);
            PG8_WAIT_V(6); PG8_BAR; PG8_MMA(1, 1, At, B1); PG8_BAR;
            PG8_LDB(B0, 1, 0); PG8_SCHED; PG8_LDA(At, 1, 0); PG8_STAGE(PG8_SA(0, 1), a2 + hstep, voffA);
            PG8_WAIT_L(8); PG8_BAR; PG8_WAIT_L(0); PG8_MMA(0, 0, At, B0); PG8_BAR; PG8_SCHED;
            PG8_LDB(B1, 1, 1); PG8_STAGE(PG8_SB(1, 0), b3, voffB);
            PG8_BAR; PG8_WAIT_L(0); PG8_MMA(0, 1, At, B1); PG8_BAR;
            PG8_LDA(At, 1, 1); PG8_STAGE(PG8_SA(1, 0), a3, voffA);
            PG8_BAR; PG8_WAIT_L(0); PG8_MMA(1, 0, At, B0); PG8_BAR; PG8_SCHED;
            PG8_STAGE(PG8_SB(1, 1), b3 + hstep, voffB);
            PG8_WAIT_V(6); PG8_BAR; PG8_MMA(1, 1, At, B1); PG8_BAR;
            }
        }
        if constexpr (ALIGN_EPI) { if (wr == 0) PG8_BAR; }
        { int l2_ = lane_id_v(); asm volatile("" : "+v"(l2_)); const int fr_ = l2_ & 15, fq_ = l2_ >> 4;
          E(acc, cur, wr, wc, fr_, fq_); }
        const bool keep_acc = Epi::KEEP && E.keep(cur);
        if (!has_next) break;
        if constexpr (Epi::INIT) E.init(acc, nxt, wr, wc, fr, fq);
        else if (!keep_acc)
#pragma unroll
        for (int a = 0; a < 2; ++a)
#pragma unroll
            for (int b = 0; b < 2; ++b)
#pragma unroll
                for (int m = 0; m < 4; ++m)
#pragma unroll
                    for (int n = 0; n < 2; ++n) acc[a][b][m][n] = (f32x4){0.f, 0.f, 0.f, 0.f};
        cur = nxt; cA = nA; cB = nB; ++ui;
        if constexpr (ALIGN_EPI) { if (wr == 1) PG8_BAR; }
    }
    PG8_WAIT_V(0);
    if constexpr (!ALIGN_EPI) { if (wr == 0) PG8_BAR; }
    PG8_BAR;
#undef PG8_SA
#undef PG8_SB
#undef PG8_STAGE
#undef PG8_LDA
#undef PG8_LDB
#undef PG8_MMA
#undef PG8_WAIT_V
#undef PG8_WAIT_L
#undef PG8_BAR
#undef PG8_SCHED
}
}
constexpr int MTOK = 16384, SEQ = 2048, DM = 1024, NLAYER = 4, DFF = 4096;
constexpr int WIN_SRC = 6824, WIN_N = 6912;
constexpr float EPS = 1e-6f, LOG2E = 1.4426950408889634f;
constexpr float QSCALE64 = 0.125f * LOG2E;
constexpr float QSCALE96 = 0.10206207261596575f * LOG2E;
constexpr size_t MiB = 1u << 20;
constexpr size_t WS_CTL = 0, WS_SSQX = 1 * MiB, WS_SSQD = 2 * MiB, WS_LF = 4 * MiB, WS_CUM = 4 * MiB + 512 * 1024, WS_ROPE = 5 * MiB;
constexpr size_t WS_WIN = 8 * MiB, WS_WQUP = 8 * MiB + 14155776, WS_WKVUP = 23 * MiB - 524288 - 65536 * 2, WS_WBR = 23 * MiB, WS_WOUT = 26 * MiB, WS_WFF1 = 28 * MiB, WS_WFF2 = 36 * MiB;
static_assert(WS_WQUP + 768 * 384 * 2 <= WS_WKVUP && WS_WKVUP + 1024 * 256 * 2 <= WS_WBR, "weight map");
constexpr size_t WS_XB = 44 * MiB, WS_G = 76 * MiB, WS_Y = 172 * MiB, WS_QD = 172 * MiB, WS_KVD = 184 * MiB;
constexpr size_t WS_R1 = 220 * MiB;
constexpr size_t WS_QA = WS_R1, WS_KA = WS_R1 + 16 * MiB, WS_VA = WS_R1 + 32 * MiB, WS_QC = WS_R1 + 48 * MiB, WS_KC = WS_R1 + 64 * MiB, WS_VC = WS_R1 + 80 * MiB;
constexpr size_t WS_QB = WS_R1 + 96 * MiB, WS_KBN = WS_R1 + 120 * MiB, WS_KR = WS_R1 + 136 * MiB, WS_VB = WS_R1 + 137 * MiB, WS_END = WS_R1 + 153 * MiB;
constexpr size_t WS_H = WS_R1, WS_MS = WS_R1, WS_MG = WS_R1 + 64 * MiB;

typedef unsigned short bf16;
typedef float f32x4 __attribute__((ext_vector_type(4)));
typedef float f32x2 __attribute__((ext_vector_type(2)));
typedef float f32x16 __attribute__((ext_vector_type(16)));
typedef unsigned u32x4 __attribute__((ext_vector_type(4)));
typedef unsigned u32x2 __attribute__((ext_vector_type(2)));
typedef short bf16x8 __attribute__((ext_vector_type(8)));
typedef __bf16 bf16x2_t __attribute__((ext_vector_type(2)));
#define LAS __attribute__((address_space(3)))

__device__ __forceinline__ unsigned pk2(float lo, float hi) { f32x2 v = {lo, hi}; bf16x2_t b = __builtin_convertvector(v, bf16x2_t); return __builtin_bit_cast(unsigned, b); }
__device__ __forceinline__ u32x4 pk8(f32x4 a, f32x4 b) { u32x4 w; w.x = pk2(a[0], a[1]); w.y = pk2(a[2], a[3]); w.z = pk2(b[0], b[1]); w.w = pk2(b[2], b[3]); return w; }
__device__ __forceinline__ float bf_lo(unsigned w) { return __uint_as_float(w << 16); }
__device__ __forceinline__ float bf_hi(unsigned w) { return __uint_as_float(w & 0xffff0000u); }
__device__ __forceinline__ float sum4(f32x4 a) { return (a[0] + a[1]) + (a[2] + a[3]); }
__device__ __forceinline__ float sq4(f32x4 a) { return (a[0] * a[0] + a[1] * a[1]) + (a[2] * a[2] + a[3] * a[3]); }
__device__ __forceinline__ float swz16(float v) { return __int_as_float(__builtin_amdgcn_ds_swizzle(__float_as_int(v), 0x401F)); }
__device__ __forceinline__ float half_sum(float m) { auto rr = __builtin_amdgcn_permlane32_swap(__float_as_uint(m), __float_as_uint(m), false, false); return __uint_as_float(rr[0]) + __uint_as_float(rr[1]); }
__device__ __forceinline__ float red_fq(float s) { s += swz16(s); return half_sum(s); }
__device__ __forceinline__ float bperm(int srclane, float v) { return __int_as_float(__builtin_amdgcn_ds_bpermute(srclane << 2, __float_as_int(v))); }
__device__ __forceinline__ float sigmoidf_(float z) { return __builtin_amdgcn_rcpf(1.0f + __builtin_amdgcn_exp2f(-z * LOG2E)); }
__device__ __forceinline__ float logsigmoidf_(float z) { return fminf(z, 0.f) - __logf(1.0f + __expf(-fabsf(z))); }

template <int N4, int STRIDE> __device__ __forceinline__ void row_rstd(float (&rs)[2][4], const float* slots, int row0, float invdim, int fq) {
#pragma unroll
    for (int ai = 0; ai < 2; ++ai)
#pragma unroll
        for (int m = 0; m < 4; ++m) { const f32x4* s = (const f32x4*)(slots + (size_t)(row0 + ai * 128 + m * 16) * STRIDE);
            float t = (fq < N4) ? sum4(s[fq < N4 ? fq : 0]) : 0.f;
            t = red_fq(t);
            rs[ai][m] = rsqrtf(t * invdim + EPS); }
}
__device__ __forceinline__ void rope8(f32x4& v0, f32x4& v1, const float* rope, int pos, int fq) {
    const f32x4* t = (const f32x4*)(rope + (size_t)pos * 32 + 8 * (fq & 1));
    const f32x4 c0 = t[0], c1 = t[1], s0 = t[4], s1 = t[5];
    f32x4 o0, o1;
#pragma unroll
    for (int j = 0; j < 4; ++j) { auto r0 = __builtin_amdgcn_permlane32_swap(__float_as_uint(v0[j]), __float_as_uint(v0[j]), false, false), r1 = __builtin_amdgcn_permlane32_swap(__float_as_uint(v1[j]), __float_as_uint(v1[j]), false, false);
        o0[j] = __uint_as_float(fq < 2 ? r0[1] : r0[0]); o1[j] = __uint_as_float(fq < 2 ? r1[1] : r1[0]); }
    const float sg = (fq < 2) ? -1.f : 1.f;
    v0 = v0 * c0 + sg * (o0 * s0); v1 = v1 * c1 + sg * (o1 * s1);
}


constexpr int SPARE_OFF = 131072, SPARE_RS = SPARE_OFF, SPARE_BG = SPARE_OFF + 7168;
__device__ __forceinline__ void stage_rstd(LAS unsigned char* lds, const pg8::StaticOrder& S, const float* ssq, const float* bgate, int tid) {
    LAS float* rs = (LAS float*)(lds + SPARE_RS); LAS float* bg = (LAS float*)(lds + SPARE_BG);
    for (int e = tid; e < 7 * 256; e += 512) { const int i = e >> 8, r = e & 255; pg8::Unit u;
        if (S.next(i, u)) { const f32x4* sp = (const f32x4*)(ssq + (size_t)(u.pm * 256 + r) * 16); const f32x4 a = sp[0], b = sp[1], c = sp[2], d = sp[3];
            rs[e] = rsqrtf(((sum4(a) + sum4(b)) + (sum4(c) + sum4(d))) * (1.0f / 1024.0f) + EPS);
            if (bgate) bg[e] = (u.pn >= 12 && u.pn < 24) ? bgate[256 * (u.pn - 12) + r] : 0.f; } }
    __syncthreads();
}
__device__ __forceinline__ void row_rstd_lds(float (&rs)[2][4], const LAS float* tab, int ord, int wr, int fr) {
#pragma unroll
    for (int ai = 0; ai < 2; ++ai)
#pragma unroll
        for (int m = 0; m < 4; ++m) rs[ai][m] = tab[ord * 256 + ai * 128 + wr * 64 + m * 16 + fr];
}
typedef const pg8::f32x4 (&AccRef)[2][2][4][2];

struct EpiWin {
    static constexpr bool PERM = true, KEEP = false, INIT = false; __device__ __forceinline__ bool keep(const pg8::Unit&) const { return false; }
    const LAS float* sp; bf16 *QA, *G, *QD, *KVD, *KR; float *LF, *ssqd;
    const float *gna, *gnc, *gnr, *bgate, *bforget, *rope;
    __device__ __forceinline__ void operator()(AccRef acc, const pg8::Unit& u, int wr, int wc, int fr, int fq) const {
        const int row0 = u.pm * 256 + wr * 64 + fr; const int pn = u.pn;
        float rs[2][4]; row_rstd_lds(rs, sp, u.ord, wr, fr);
        if (pn < 12) {
            const int seg = pn >> 1, head = 4 * (pn & 1) + wc; const bool isV = (seg == 2 || seg == 5);
            bf16* out = QA + (size_t)seg * ((size_t)MTOK * 512) + head * 64 + 8 * fq;
            const float* gp = (seg < 3 ? gna : gnc) + ((seg == 1 || seg == 4) ? 64 : 0) + 8 * fq;
            const float post = (seg == 0 || seg == 3) ? QSCALE64 : 1.0f;
            f32x4 g4[2][2];
#pragma unroll
            for (int bj = 0; bj < 2; ++bj)
#pragma unroll
                for (int n = 0; n < 2; ++n) g4[bj][n] = isV ? (f32x4){1.f, 1.f, 1.f, 1.f} : *(const f32x4*)(gp + 32 * bj + 4 * n);
#pragma unroll
            for (int ai = 0; ai < 2; ++ai)
#pragma unroll
                for (int m = 0; m < 4; ++m) {
                    const float r = rs[ai][m]; f32x4 v[2][2]; float ss = 0.f;
#pragma unroll
                    for (int bj = 0; bj < 2; ++bj)
#pragma unroll
                        for (int n = 0; n < 2; ++n) { v[bj][n] = acc[ai][bj][m][n] * r; ss += sq4(v[bj][n]); }
                    float sc = 1.0f;
                    if (!isV) { ss = red_fq(ss); sc = rsqrtf(ss * (1.0f / 64.0f) + EPS) * post; }
                    bf16* rowp = out + (size_t)(row0 + ai * 128 + m * 16) * 512;
#pragma unroll
                    for (int bj = 0; bj < 2; ++bj) *(u32x4*)(rowp + 32 * bj) = pk8(v[bj][0] * sc * g4[bj][0], v[bj][1] * sc * g4[bj][1]);
                }
        } else if (pn < 24) {
            const int col0 = 256 * (pn - 12) + 32 * wc + 8 * fq;
            f32x4 b4[2][2];
#pragma unroll
            for (int bj = 0; bj < 2; ++bj)
#pragma unroll
                for (int n = 0; n < 2; ++n) b4[bj][n] = *(const LAS f32x4*)(sp + 7 * 256 + u.ord * 256 + 32 * wc + 8 * fq + 128 * bj + 4 * n);
#pragma unroll
            for (int ai = 0; ai < 2; ++ai)
#pragma unroll
                for (int m = 0; m < 4; ++m) {
                    const float r = rs[ai][m]; bf16* rowp = G + (size_t)(row0 + ai * 128 + m * 16) * 3072 + col0;
#pragma unroll
                    for (int bj = 0; bj < 2; ++bj) { f32x4 a = acc[ai][bj][m][0] * r + b4[bj][0], b = acc[ai][bj][m][1] * r + b4[bj][1];
#pragma unroll
                        for (int j = 0; j < 4; ++j) { a[j] = sigmoidf_(a[j]); b[j] = sigmoidf_(b[j]); }
                        *(u32x4*)(rowp + 128 * bj) = pk8(a, b); }
                }
        } else {
#pragma unroll
            for (int bj = 0; bj < 2; ++bj) {
                const int cb = 256 * (pn - 24) + 128 * bj + 32 * wc;
                if (cb < 640) {
                    bf16* outp = (cb < 384) ? (QD + cb + 8 * fq) : (KVD + (cb - 384) + 8 * fq); const int ld = (cb < 384) ? 384 : 256;
#pragma unroll
                    for (int ai = 0; ai < 2; ++ai)
#pragma unroll
                        for (int m = 0; m < 4; ++m) { const int row = row0 + ai * 128 + m * 16; const float r = rs[ai][m];
                            const f32x4 a = acc[ai][bj][m][0] * r, b = acc[ai][bj][m][1] * r;
                            *(u32x4*)(outp + (size_t)row * ld) = pk8(a, b);
                            const float ss = red_fq(sq4(a) + sq4(b));
                            if (fq == 0) ssqd[(size_t)row * 32 + (cb >> 5)] = ss; }
                } else if (cb == 640) {
                    const f32x4 g0 = *(const f32x4*)(gnr + 32 + 8 * fq), g1 = *(const f32x4*)(gnr + 32 + 8 * fq + 4);
#pragma unroll
                    for (int ai = 0; ai < 2; ++ai)
#pragma unroll
                        for (int m = 0; m < 4; ++m) { const int row = row0 + ai * 128 + m * 16; const float r = rs[ai][m];
                            f32x4 a = acc[ai][bj][m][0] * r, b = acc[ai][bj][m][1] * r;
                            const float sc = rsqrtf(red_fq(sq4(a) + sq4(b)) * (1.0f / 32.0f) + EPS);
                            a = a * sc * g0; b = b * sc * g1; rope8(a, b, rope, row & (SEQ - 1), fq);
                            *(u32x4*)(KR + (size_t)row * 32 + 8 * fq) = pk8(a, b); }
                } else if (cb == 672) {
                    const f32x4 bf0 = *(const f32x4*)(bforget), bf1 = *(const f32x4*)(bforget + 4);
#pragma unroll
                    for (int ai = 0; ai < 2; ++ai)
#pragma unroll
                        for (int m = 0; m < 4; ++m) { const int row = row0 + ai * 128 + m * 16; const float r = rs[ai][m];
                            f32x4 a = acc[ai][bj][m][0] * r + bf0, b = acc[ai][bj][m][1] * r + bf1;
#pragma unroll
                            for (int j = 0; j < 4; ++j) { a[j] = logsigmoidf_(a[j]); b[j] = logsigmoidf_(b[j]); }
                            if (fq == 0) { *(f32x4*)(LF + (size_t)row * 8) = a; *(f32x4*)(LF + (size_t)row * 8 + 4) = b; } }
                }
            }
        }
    }
};

struct EpiQup {
    static constexpr bool PERM = true, KEEP = false, INIT = false; __device__ __forceinline__ bool keep(const pg8::Unit&) const { return false; }
    const float* ssqd; bf16* QB; const float *gnn, *gnr, *rope;
    __device__ __forceinline__ void operator()(AccRef acc, const pg8::Unit& u, int wr, int wc, int fr, int fq) const {
        const int row0 = u.pm * 256 + wr * 64 + fr; const int pn = u.pn;
        float rs[2][4]; row_rstd<3, 32>(rs, ssqd, row0, 1.0f / 384.0f, fq);
        if (pn < 2) {
            const int head = 4 * pn + wc; f32x4 g4[2][2];
#pragma unroll
            for (int bj = 0; bj < 2; ++bj)
#pragma unroll
                for (int n = 0; n < 2; ++n) g4[bj][n] = *(const f32x4*)(gnn + 32 * bj + 8 * fq + 4 * n);
#pragma unroll
            for (int ai = 0; ai < 2; ++ai)
#pragma unroll
                for (int m = 0; m < 4; ++m) { const float r = rs[ai][m]; f32x4 v[2][2]; float ss = 0.f;
#pragma unroll
                    for (int bj = 0; bj < 2; ++bj)
#pragma unroll
                        for (int n = 0; n < 2; ++n) { v[bj][n] = acc[ai][bj][m][n] * r; ss += sq4(v[bj][n]); }
                    const float sc = rsqrtf(red_fq(ss) * (1.0f / 64.0f) + EPS) * QSCALE96;
                    bf16* rowp = QB + (size_t)(row0 + ai * 128 + m * 16) * 768 + head * 96 + 8 * fq;
#pragma unroll
                    for (int bj = 0; bj < 2; ++bj) *(u32x4*)(rowp + 32 * bj) = pk8(v[bj][0] * sc * g4[bj][0], v[bj][1] * sc * g4[bj][1]); }
        } else {
            const f32x4 g0 = *(const f32x4*)(gnr + 8 * fq), g1 = *(const f32x4*)(gnr + 8 * fq + 4);
#pragma unroll
            for (int ai = 0; ai < 2; ++ai)
#pragma unroll
                for (int m = 0; m < 4; ++m) { const int row = row0 + ai * 128 + m * 16; const float r = rs[ai][m];
#pragma unroll
                    for (int bj = 0; bj < 2; ++bj) { const int head = 4 * bj + wc;
                        f32x4 a = acc[ai][bj][m][0] * r, b = acc[ai][bj][m][1] * r;
                        const float sc = rsqrtf(red_fq(sq4(a) + sq4(b)) * (1.0f / 32.0f) + EPS);
                        a = a * sc * g0; b = b * sc * g1; rope8(a, b, rope, row & (SEQ - 1), fq);
                        *(u32x4*)(QB + (size_t)row * 768 + head * 96 + 64 + 8 * fq) = pk8(a * QSCALE96, b * QSCALE96); } }
        }
    }
};
struct EpiKvup {
    static constexpr bool PERM = true, KEEP = false, INIT = false; __device__ __forceinline__ bool keep(const pg8::Unit&) const { return false; }
    const float* ssqd; bf16 *KBN, *VB; const float* gnn;
    __device__ __forceinline__ void operator()(AccRef acc, const pg8::Unit& u, int wr, int wc, int fr, int fq) const {
        const int row0 = u.pm * 256 + wr * 64 + fr; const int pn = u.pn;
        float rs[2][4]; row_rstd<2, 32>(rs, ssqd + 12, row0, 1.0f / 256.0f, fq);
        if (pn < 2) {
            const int head = 4 * pn + wc; f32x4 g4[2][2];
#pragma unroll
            for (int bj = 0; bj < 2; ++bj)
#pragma unroll
                for (int n = 0; n < 2; ++n) g4[bj][n] = *(const f32x4*)(gnn + 64 + 32 * bj + 8 * fq + 4 * n);
#pragma unroll
            for (int ai = 0; ai < 2; ++ai)
#pragma unroll
                for (int m = 0; m < 4; ++m) { const float r = rs[ai][m]; f32x4 v[2][2]; float ss = 0.f;
#pragma unroll
                    for (int bj = 0; bj < 2; ++bj)
#pragma unroll
                        for (int n = 0; n < 2; ++n) { v[bj][n] = acc[ai][bj][m][n] * r; ss += sq4(v[bj][n]); }
                    const float sc = rsqrtf(red_fq(ss) * (1.0f / 64.0f) + EPS);
                    bf16* rowp = KBN + (size_t)(row0 + ai * 128 + m * 16) * 512 + head * 64 + 8 * fq;
#pragma unroll
                    for (int bj = 0; bj < 2; ++bj) *(u32x4*)(rowp + 32 * bj) = pk8(v[bj][0] * sc * g4[bj][0], v[bj][1] * sc * g4[bj][1]); }
        } else {
            const int col0 = 256 * (pn - 2) + 32 * wc + 8 * fq;
#pragma unroll
            for (int ai = 0; ai < 2; ++ai)
#pragma unroll
                for (int m = 0; m < 4; ++m) { const float r = rs[ai][m]; bf16* rowp = VB + (size_t)(row0 + ai * 128 + m * 16) * 512 + col0;
#pragma unroll
                    for (int bj = 0; bj < 2; ++bj) *(u32x4*)(rowp + 128 * bj) = pk8(acc[ai][bj][m][0] * r, acc[ai][bj][m][1] * r); }
        }
    }
};
typedef pg8::f32x4 (&AccMut)[2][2][4][2];
struct EpiMerge {
    static constexpr bool PERM = true, KEEP = true, INIT = false; __device__ __forceinline__ bool keep(const pg8::Unit& u) const { return u.pz < 2; }
    const bf16* G; bf16* MG;
    __device__ __forceinline__ void operator()(AccMut acc, const pg8::Unit& u, int wr, int wc, int fr, int fq) const {
        const int row0 = u.pm * 256 + wr * 64 + fr; const int col0 = u.pn * 256 + 32 * wc + 8 * fq; const int z = u.pz;
#pragma unroll
        for (int ai = 0; ai < 2; ++ai) {
            u32x4 gn[4][2], gd[4][2];
#pragma unroll
            for (int m = 0; m < 4; ++m)
#pragma unroll
                for (int bj = 0; bj < 2; ++bj) { const bf16* gp = G + (size_t)(row0 + ai * 128 + m * 16) * 3072 + 1024 * z + col0 + 128 * bj;
                    gn[m][bj] = *(const u32x4*)gp; gd[m][bj] = (z < 2) ? *(const u32x4*)(gp + 1024) : (u32x4){0x3f803f80u, 0x3f803f80u, 0x3f803f80u, 0x3f803f80u}; }
#pragma unroll
            for (int m = 0; m < 4; ++m)
#pragma unroll
                for (int bj = 0; bj < 2; ++bj) { const u32x4 n4 = gn[m][bj], d4 = gd[m][bj];
                    f32x4 na = {bf_lo(n4.x), bf_hi(n4.x), bf_lo(n4.y), bf_hi(n4.y)}, nb = {bf_lo(n4.z), bf_hi(n4.z), bf_lo(n4.w), bf_hi(n4.w)};
                    if (z < 2) { const f32x4 da = {bf_lo(d4.x), bf_hi(d4.x), bf_lo(d4.y), bf_hi(d4.y)}, db = {bf_lo(d4.z), bf_hi(d4.z), bf_lo(d4.w), bf_hi(d4.w)};
#pragma unroll
                        for (int j = 0; j < 4; ++j) { na[j] *= __builtin_amdgcn_rcpf(fmaxf(da[j], 1e-30f)); nb[j] *= __builtin_amdgcn_rcpf(fmaxf(db[j], 1e-30f)); } }
                    const f32x4 a = acc[ai][bj][m][0] * na, b = acc[ai][bj][m][1] * nb;
                    if (z < 2) { acc[ai][bj][m][0] = a; acc[ai][bj][m][1] = b; }
                    else *(u32x4*)(MG + (size_t)(row0 + ai * 128 + m * 16) * 1024 + col0 + 128 * bj) = pk8(a, b); }
        }
    }
};
struct EpiRes {
    static constexpr bool PERM = true, KEEP = false, INIT = true; __device__ __forceinline__ bool keep(const pg8::Unit&) const { return false; }
    const float* Xin; float* X; bf16* XB; float* ssqx; int wr_xb;
    __device__ __forceinline__ void init(pg8::f32x4 (&acc)[2][2][4][2], const pg8::Unit& u, int wr, int wc, int fr, int fq) const {
        const int row0 = u.pm * 256 + wr * 64 + fr; const int col0 = u.pn * 256 + 32 * wc + 8 * fq;
#pragma unroll
        for (int ai = 0; ai < 2; ++ai)
#pragma unroll
            for (int m = 0; m < 4; ++m)
#pragma unroll
                for (int bj = 0; bj < 2; ++bj) { const float* xp = Xin + (size_t)(row0 + ai * 128 + m * 16) * 1024 + col0 + 128 * bj; acc[ai][bj][m][0] = *(const f32x4*)xp; acc[ai][bj][m][1] = *(const f32x4*)(xp + 4); }
    }
    __device__ __forceinline__ void operator()(AccRef acc, const pg8::Unit& u, int wr, int wc, int fr, int fq) const {
        const int row0 = u.pm * 256 + wr * 64 + fr; const int col0 = u.pn * 256 + 32 * wc + 8 * fq;
#pragma unroll
        for (int ai = 0; ai < 2; ++ai)
#pragma unroll
            for (int m = 0; m < 4; ++m) { const size_t row = (size_t)(row0 + ai * 128 + m * 16); float ss = 0.f;
#pragma unroll
                for (int bj = 0; bj < 2; ++bj) { float* xp = X + row * 1024 + col0 + 128 * bj;
                    const f32x4 a = acc[ai][bj][m][0], b = acc[ai][bj][m][1];
                    *(f32x4*)xp = a; *(f32x4*)(xp + 4) = b; ss += sq4(a) + sq4(b);
                    if (wr_xb) *(u32x4*)(XB + row * 1024 + col0 + 128 * bj) = pk8(a, b); }
                if (wr_xb) { ss = red_fq(ss);
                    if (fq == 0) ssqx[row * 16 + 4 * u.pn + wc] = ss; } }
    }
};
struct EpiFF1 {
    static constexpr bool PERM = true, KEEP = false, INIT = false; __device__ __forceinline__ bool keep(const pg8::Unit&) const { return false; }
    const LAS float* sp; bf16* H;
    __device__ __forceinline__ void operator()(AccRef acc, const pg8::Unit& u, int wr, int wc, int fr, int fq) const {
        const int row0 = u.pm * 256 + wr * 64 + fr; const int col0 = u.pn * 256 + 32 * wc + 8 * fq;
        float rs[2][4]; row_rstd_lds(rs, sp, u.ord, wr, fr);
#pragma unroll
        for (int ai = 0; ai < 2; ++ai)
#pragma unroll
            for (int m = 0; m < 4; ++m) { const float r = rs[ai][m]; bf16* rowp = H + (size_t)(row0 + ai * 128 + m * 16) * 4096 + col0;
#pragma unroll
                for (int bj = 0; bj < 2; ++bj) { f32x4 a = acc[ai][bj][m][0] * r, b = acc[ai][bj][m][1] * r;
#pragma unroll
                    for (int j = 0; j < 4; ++j) { a[j] = fmaxf(a[j], 0.f); b[j] = fmaxf(b[j], 0.f); }
                    *(u32x4*)(rowp + 128 * bj) = pk8(a * a, b * b); } }
    }
};
namespace att {
constexpr int KOFF = 0, KBUF = 64 * 208, VOFF = 2 * KBUF, VSTR = 192, VBUF = 64 * VSTR, KBOFF = VOFF + 2 * VBUF, RELOFF = KBOFF + 512, TKOFF = RELOFF + 2432, LDS_END = TKOFF + 16;
__device__ __forceinline__ int crow(int r, int hi) { return (r & 3) + 8 * (r >> 2) + 4 * hi; }
typedef short v4i16_t __attribute__((ext_vector_type(4)));
typedef short s16x4 __attribute__((ext_vector_type(4)));
__device__ __forceinline__ s16x4 vtr(const LAS unsigned char* p) { return __builtin_bit_cast(s16x4, __builtin_amdgcn_ds_read_tr16_b64_v4i16((LAS v4i16_t*)p)); }
__device__ __forceinline__ float hmax(float m) { auto rr = __builtin_amdgcn_permlane32_swap(__float_as_uint(m), __float_as_uint(m), false, false); return fmaxf(__uint_as_float(rr[0]), __uint_as_float(rr[1])); }
__device__ __forceinline__ float hsum(float m) { auto rr = __builtin_amdgcn_permlane32_swap(__float_as_uint(m), __float_as_uint(m), false, false); return __uint_as_float(rr[0]) + __uint_as_float(rr[1]); }

struct P { const bf16 *QA, *KA, *VA, *QB, *KBN, *KR, *VB, *QC, *KC, *VC; const float *cum, *relb; bf16 *YA, *YB, *YC; };

template <int TYPE, int ND0, int KSTR> __device__ __forceinline__ void tile(LAS unsigned char* lds, int buf, int t, int w_lo, int w_hi, int n, int qrel, int lane, int r32, int hi,
        const bf16x8 (&qr)[ND0], float& m_run, float& l_run, f32x16& o0, f32x16& o1, f32x16& negm) {
    const LAS unsigned char* kb = lds + KOFF + buf * KBUF + r32 * KSTR + hi * 16;
    bf16x8 ka[ND0], kc[ND0];
#pragma unroll
    for (int d0 = 0; d0 < ND0; ++d0) { ka[d0] = *(const LAS bf16x8*)(kb + d0 * 32); kc[d0] = *(const LAS bf16x8*)(kb + 32 * KSTR + d0 * 32); }
    const LAS unsigned char* vb = lds + VOFF + buf * VBUF + (4 * hi + ((lane & 15) >> 2)) * VSTR + (16 * ((lane >> 4) & 1) + 4 * (lane & 3)) * 2;
    s16x4 vf[4][4];
#pragma unroll
    for (int ks = 0; ks < 4; ++ks) { vf[ks][0] = vtr(vb + (16 * ks) * VSTR); vf[ks][1] = vtr(vb + (16 * ks + 8) * VSTR); vf[ks][2] = vtr(vb + (16 * ks) * VSTR + 64); vf[ks][3] = vtr(vb + (16 * ks + 8) * VSTR + 64); }
    f32x4 kbv[8];
    if (TYPE == 0) { const LAS f32x4* kbi = (const LAS f32x4*)(lds + KBOFF + buf * 256);
#pragma unroll
        for (int g = 0; g < 4; ++g) { kbv[g] = kbi[2 * g + hi]; kbv[4 + g] = kbi[8 + 2 * g + hi]; } }
    asm volatile("" ::: "memory");
    const int rel = n - t;
    f32x16 cin = negm;
    if (TYPE == 2 && rel >= 5) { const float c = ((const LAS float*)(lds + RELOFF))[512];
#pragma unroll
        for (int r = 0; r < 16; ++r) cin[r] += c; }
    f32x16 p0 = cin, p1 = cin;
#pragma unroll
    for (int d0 = 0; d0 < ND0; ++d0) {
        p0 = __builtin_amdgcn_mfma_f32_32x32x16_bf16(ka[d0], qr[d0], p0, 0, 0, 0);
        p1 = __builtin_amdgcn_mfma_f32_32x32x16_bf16(kc[d0], qr[d0], p1, 0, 0, 0);
    }
    if (TYPE == 0) {
#pragma unroll
        for (int g = 0; g < 4; ++g)
#pragma unroll
            for (int j = 0; j < 4; ++j) { p0[4 * g + j] += kbv[g][j]; p1[4 * g + j] += kbv[4 + g][j]; }
        if (t == w_hi) {
#pragma unroll
            for (int r = 0; r < 16; ++r) { const int kr_ = crow(r, hi); if (kr_ > qrel) p0[r] = -1e30f; if (kr_ + 32 > qrel) p1[r] = -1e30f; }
        }
    }
    if (TYPE == 2 && rel < 5) {
        const LAS float* rb = (const LAS float*)(lds + RELOFF) + (qrel + 64 * rel + 256 - 4 * hi - 59);
#pragma unroll
        for (int r = 0; r < 16; ++r) { p0[r] += rb[59 - ((r & 3) + 8 * (r >> 2))]; p1[r] += rb[27 - ((r & 3) + 8 * (r >> 2))]; }
    }
    if (t == w_lo) {
        float mx = fmaxf(p0[0], p1[0]);
#pragma unroll
        for (int r = 1; r < 16; ++r) mx = fmaxf(mx, fmaxf(p0[r], p1[r]));
        mx = hmax(mx); m_run = mx;
#pragma unroll
        for (int r = 0; r < 16; ++r) { p0[r] -= mx; p1[r] -= mx; negm[r] = -mx; }
    }
    float ls = 0.f;
#pragma unroll
    for (int r = 0; r < 16; ++r) { p0[r] = __builtin_amdgcn_exp2f(p0[r]); p1[r] = __builtin_amdgcn_exp2f(p1[r]); ls += p0[r] + p1[r]; }
    const float lrow = hsum(ls);
    if (__builtin_amdgcn_ballot_w64(lrow > 1048576.0f) != 0ull) {
        float pm = fmaxf(p0[0], p1[0]);
#pragma unroll
        for (int r = 1; r < 16; ++r) pm = fmaxf(pm, fmaxf(p0[r], p1[r]));
        pm = hmax(pm);
        const float dl = (lrow > 1048576.0f) ? __builtin_amdgcn_logf(pm) : 0.f;
        const float sc = __builtin_amdgcn_exp2f(-dl);
        m_run += dl; l_run *= sc; ls *= sc;
#pragma unroll
        for (int r = 0; r < 16; ++r) { p0[r] *= sc; p1[r] *= sc; o0[r] *= sc; o1[r] *= sc; negm[r] = -m_run; }
    }
    l_run += ls;
#pragma unroll
    for (int ks = 0; ks < 4; ++ks) {
        u32x4 pw;
        if (ks < 2) { pw.x = pk2(p0[8 * ks], p0[8 * ks + 1]); pw.y = pk2(p0[8 * ks + 2], p0[8 * ks + 3]); pw.z = pk2(p0[8 * ks + 4], p0[8 * ks + 5]); pw.w = pk2(p0[8 * ks + 6], p0[8 * ks + 7]); }
        else { const int k2 = ks - 2; pw.x = pk2(p1[8 * k2], p1[8 * k2 + 1]); pw.y = pk2(p1[8 * k2 + 2], p1[8 * k2 + 3]); pw.z = pk2(p1[8 * k2 + 4], p1[8 * k2 + 5]); pw.w = pk2(p1[8 * k2 + 6], p1[8 * k2 + 7]); }
        const bf16x8 pb = __builtin_bit_cast(bf16x8, pw);
        const bf16x8 va0 = __builtin_shufflevector(vf[ks][0], vf[ks][1], 0, 1, 2, 3, 4, 5, 6, 7), va1 = __builtin_shufflevector(vf[ks][2], vf[ks][3], 0, 1, 2, 3, 4, 5, 6, 7);
        o0 = __builtin_amdgcn_mfma_f32_32x32x16_bf16(va0, pb, o0, 0, 0, 0);
        o1 = __builtin_amdgcn_mfma_f32_32x32x16_bf16(va1, pb, o1, 0, 0, 0);
    }
}

template <int TYPE> __device__ __forceinline__ int unit(const P& p, LAS unsigned char* lds, int b, int h, int qb, int wave0, bool pre, unsigned nx, int G,
        u32x4& kA, u32x4& vA, u32x4& k2A, float& cbA, u32x4& kB, u32x4& vB, u32x4& k2B, float& cbB) {
    constexpr int DQK = (TYPE == 1) ? 96 : 64, ND0 = DQK / 16, KSTR = DQK * 2 + 16;
    int tid_ = wave0 * 64 + lane_id_v(); asm volatile("" : "+v"(tid_));
    const int tid = tid_, lane = tid & 63, r32 = lane & 31, hi = lane >> 5; const int w = __builtin_amdgcn_readfirstlane(tid >> 6);
    const size_t rowbase = (size_t)b * SEQ;
    const bf16* Qp = (TYPE == 0) ? p.QA : (TYPE == 1) ? p.QB : p.QC; const bf16* Kp = (TYPE == 0) ? p.KA : (TYPE == 1) ? p.KBN : p.KC; const bf16* Vp = (TYPE == 0) ? p.VA : (TYPE == 1) ? p.VB : p.VC;
    bf16* Yp = (TYPE == 0) ? p.YA : (TYPE == 1) ? p.YB : p.YC;
    constexpr int QPITCH = (TYPE == 1) ? 768 : 512;
    const int n = 4 * qb + (w >> 1);
    const int u_lo = (TYPE == 2) ? (4 * qb - 8 > 0 ? 4 * qb - 8 : 0) : 0, u_hi = 4 * qb + 3;
    const int w_lo = (TYPE == 2) ? (n - 8 > 0 ? n - 8 : 0) : 0, w_hi = n;
    bf16x8 qr[ND0];
    { const bf16* qrow = Qp + (rowbase + 256 * qb + 32 * w + r32) * QPITCH + h * DQK + 8 * hi;
#pragma unroll
      for (int d0 = 0; d0 < ND0; ++d0) qr[d0] = *(const bf16x8*)(qrow + 16 * d0); }
    if (TYPE == 2) { LAS float* rt = (LAS float*)(lds + RELOFF); for (int i = tid; i < 592; i += 512) rt[i] = p.relb[h * 513 + (i < 512 ? i : 512)] * LOG2E; }
    const int srow = tid >> 3, sch = tid & 7;
    const bf16* kg = Kp + (rowbase + srow) * 512 + h * 64 + sch * 8;
    const bf16* vg = Vp + (rowbase + srow) * 512 + h * 64 + sch * 8;
    const bf16* krg = p.KR + (rowbase + ((tid & 255) >> 2)) * 32 + (tid & 3) * 8;
    const float* cg_ = p.cum + (size_t)(b * 8 + h) * SEQ + (tid & 63);
    LAS int* tk = (LAS int*)(lds + TKOFF);
#define ATT_LOAD(t, S) do { const int tl_ = (t) < u_hi ? (t) : u_hi;     \
        k##S = *(const u32x4*)(kg + (size_t)tl_ * 64 * 512); v##S = *(const u32x4*)(vg + (size_t)tl_ * 64 * 512); \
        if (TYPE == 1) k2##S = *(const u32x4*)(krg + (size_t)tl_ * 64 * 32); if (TYPE == 0) cb##S = cg_[tl_ * 64]; } while (0)
#define ATT_LOAD_NEXT(j, S) do { k##S = *(const u32x4*)(nk + (size_t)(j) * 64 * 512); v##S = *(const u32x4*)(nv + (size_t)(j) * 64 * 512); \
        k2##S = *(const u32x4*)(nkr + (size_t)(j) * 64 * 32); cb##S = ncg[(j) * 64]; } while (0)
#define ATT_STORE(buf, S) do { *(LAS u32x4*)(lds + KOFF + (buf) * KBUF + srow * KSTR + sch * 16) = k##S; *(LAS u32x4*)(lds + VOFF + (buf) * VBUF + srow * VSTR + sch * 16) = v##S; \
        if (TYPE == 1 && tid < 256) *(LAS u32x4*)(lds + KOFF + (buf) * KBUF + (tid >> 2) * KSTR + 128 + (tid & 3) * 16) = k2##S; \
        if (TYPE == 0 && tid < 64) ((LAS float*)(lds + KBOFF + (buf) * 256))[tid] = -cb##S * LOG2E; } while (0)
    float m_run = 0.f, l_run = 0.f; f32x16 o0 = {}, o1 = {};
    f32x16 negm;
#pragma unroll
    for (int r = 0; r < 16; ++r) negm[r] = 0.f;
    if (!pre) { ATT_LOAD(u_lo, A); ATT_LOAD(u_lo + 1, B); }
    ATT_STORE(0, A);
    __syncthreads();
    const int qrel = 32 * (w & 1) + r32;
    int t = u_lo;
    for (; t < u_hi - 1; t += 2) {
        ATT_LOAD(t + 2, A);
        if (t >= w_lo && t <= w_hi) tile<TYPE, ND0, KSTR>(lds, 0, t, w_lo, w_hi, n, qrel, lane, r32, hi, qr, m_run, l_run, o0, o1, negm);
        ATT_STORE(1, B);
        __syncthreads();
        ATT_LOAD(t + 3, B);
        if (t + 1 >= w_lo && t + 1 <= w_hi) tile<TYPE, ND0, KSTR>(lds, 1, t + 1, w_lo, w_hi, n, qrel, lane, r32, hi, qr, m_run, l_run, o0, o1, negm);
        ATT_STORE(0, A);
        if (t == u_lo && tid == 0) tk[0] = G + (int)nx;
        __syncthreads();
    }
    const int inext = tk[0];
    {
        const bool nval = inext < 1536; const int ii = nval ? inext : 0;
        const int nqb = 7 - ii / 192, nrem = ii % 192, nq = nrem / 64, nbh = nrem % 64, nb = nbh >> 3, nh = nbh & 7;
        const int nT = (nq == 0) ? 1 : (nq == 1) ? 0 : 2;
        const int nlo = (nT == 2) ? (4 * nqb - 8 > 0 ? 4 * nqb - 8 : 0) : 0;
        const bf16* nKp = (nT == 0) ? p.KA : (nT == 1) ? p.KBN : p.KC; const bf16* nVp = (nT == 0) ? p.VA : (nT == 1) ? p.VB : p.VC;
        const size_t nrow = (size_t)nb * SEQ + (size_t)nlo * 64;
        const bf16* nk = nKp + (nrow + srow) * 512 + nh * 64 + sch * 8; const bf16* nv = nVp + (nrow + srow) * 512 + nh * 64 + sch * 8;
        const bf16* nkr = p.KR + (nrow + ((tid & 255) >> 2)) * 32 + (tid & 3) * 8; const float* ncg = p.cum + (size_t)(nb * 8 + nh) * SEQ + nlo * 64 + (tid & 63);
        ATT_LOAD_NEXT(0, A);
        if (t >= w_lo && t <= w_hi) tile<TYPE, ND0, KSTR>(lds, 0, t, w_lo, w_hi, n, qrel, lane, r32, hi, qr, m_run, l_run, o0, o1, negm);
        ATT_STORE(1, B);
        __syncthreads();
        ATT_LOAD_NEXT(1, B);
        if (t + 1 >= w_lo && t + 1 <= w_hi) tile<TYPE, ND0, KSTR>(lds, 1, t + 1, w_lo, w_hi, n, qrel, lane, r32, hi, qr, m_run, l_run, o0, o1, negm);
        __syncthreads();
    }
#undef ATT_LOAD
#undef ATT_LOAD_NEXT
#undef ATT_STORE
    const float inv = __builtin_amdgcn_rcpf(hsum(l_run));
    bf16* yrow = Yp + (rowbase + 256 * qb + 32 * w + r32) * 512 + h * 64 + 4 * hi;
#pragma unroll
    for (int g = 0; g < 4; ++g) {
        u32x2 w0, w1; w0.x = pk2(o0[4 * g] * inv, o0[4 * g + 1] * inv); w0.y = pk2(o0[4 * g + 2] * inv, o0[4 * g + 3] * inv);
        w1.x = pk2(o1[4 * g] * inv, o1[4 * g + 1] * inv); w1.y = pk2(o1[4 * g + 2] * inv, o1[4 * g + 3] * inv);
        *(u32x2*)(yrow + 8 * g) = w0; *(u32x2*)(yrow + 32 + 8 * g) = w1;
    }
    return inext;
}

__device__ __forceinline__ void phase(const P& p, LAS unsigned char* lds, unsigned* ctr, int wave0, int tid) {
    const int G = (int)gridDim.x;
    u32x4 kA = {}, vA = {}, k2A = {}, kB = {}, vB = {}, k2B = {}; float cbA = 0.f, cbB = 0.f;
    int i = (int)blockIdx.x; bool pre = false;
    while (i < 1536) {
        unsigned nx = 0u;
        if (tid == 0) nx = atomicAdd(ctr, 1u);
        const int qb = 7 - i / 192, rem = i % 192, ty = rem / 64, bh = rem % 64, b = bh >> 3, h = bh & 7;
        if (ty == 0) i = unit<1>(p, lds, b, h, qb, wave0, pre, nx, G, kA, vA, k2A, cbA, kB, vB, k2B, cbB);
        else if (ty == 1) i = unit<0>(p, lds, b, h, qb, wave0, pre, nx, G, kA, vA, k2A, cbA, kB, vB, k2B, cbB);
        else i = unit<2>(p, lds, b, h, qb, wave0, pre, nx, G, kA, vA, k2A, cbA, kB, vB, k2B, cbB);
        pre = true;
    }
}
}
__device__ __forceinline__ int headperm(int nseg, int pitch, int base) { const int ti = nseg >> 8, ct = nseg & 255, bj = ct >> 7, wc = (ct >> 5) & 3, j = ct & 31; return base + (4 * ti + wc) * pitch + 32 * bj + j; }
__device__ __forceinline__ int src_col(int map, int n) {
    if (map == 0) {
        if (n < 3072) { const int seg = n >> 9; const int base = seg == 0 ? 0 : seg == 1 ? 512 : seg == 2 ? 1024 : seg == 3 ? 2216 : seg == 4 ? 2728 : 3240; return headperm(n & 511, 64, base); }
        if (n < 6144) return 3752 + (n - 3072);
        const int tc = n - 6144;
        if (tc < 384) return 1544 + tc; if (tc < 640) return 1928 + (tc - 384); if (tc < 672) return 2184 + (tc - 640); if (tc < 680) return 1536 + (tc - 672); return -1;
    } else if (map == 1) {
        if (n < 512) return headperm(n, 96, 0);
        const int ct = n - 512, bj = ct >> 7, wc = (ct >> 5) & 3, j = ct & 31; return (4 * bj + wc) * 96 + 64 + j;
    } else if (map == 2) {
        if (n < 512) return headperm(n, 128, 0);
        const int c = n - 512; return (c >> 6) * 128 + 64 + (c & 63);
    }
    return n;
}
__device__ __forceinline__ void conv_item(const float* W, int K, int Nsrc, int Ndst, const float* ksc, bf16* WT, int map, int item, LAS float* scr, int lane) {
    const int nblk = Ndst / 32, kb = item / nblk, nb = item % nblk, k0 = 64 * kb, n0 = 32 * nb;
    const int sc = src_col(map, n0 + (lane & 31));
    float wv[32];
    { const float* wp = W + (size_t)(k0 + (lane >> 5)) * Nsrc + (sc >= 0 ? sc : 0);
#pragma unroll
      for (int i = 0; i < 32; ++i) wv[i] = wp[(size_t)(2 * i) * Nsrc]; }
    if (ksc) {
#pragma unroll
        for (int i = 0; i < 32; ++i) wv[i] *= ksc[k0 + 2 * i + (lane >> 5)];
    }
#pragma unroll
    for (int i = 0; i < 32; ++i) scr[(2 * i + (lane >> 5)) * 33 + (lane & 31)] = (sc >= 0) ? wv[i] : 0.f;
    asm volatile("s_waitcnt lgkmcnt(0)" ::: "memory");
    const int c = lane & 7;
#pragma unroll
    for (int j = 0; j < 4; ++j) { const int n = (lane >> 3) + 8 * j; const LAS float* s = scr + (8 * c) * 33 + n;
        u32x4 o; o.x = pk2(s[0 * 33], s[1 * 33]); o.y = pk2(s[2 * 33], s[3 * 33]); o.z = pk2(s[4 * 33], s[5 * 33]); o.w = pk2(s[6 * 33], s[7 * 33]);
        *(u32x4*)(WT + (size_t)(n0 + n) * K + k0 + 8 * c) = o; }
    asm volatile("s_waitcnt lgkmcnt(0)" ::: "memory");
}


#define XB_TMO      128
#define XB_XCNT(j)  (256  + 64 * (j))
#define XB_XSUB(j)  (1280 + 64 * (j))
#define XB_XGEN(j)  (2304 + 64 * (j))
#define XB_TOP      3328
#define XB_TOPGEN   3392
#define XCD_BAR_WORDS 3456
#define XB_SPIN_CAP (1u << 18)
__device__ __forceinline__ unsigned xb_ld(unsigned* p)              { return __hip_atomic_load(p, __ATOMIC_RELAXED, __HIP_MEMORY_SCOPE_AGENT); }
__device__ __forceinline__ unsigned xb_add(unsigned* p, unsigned v) { return __hip_atomic_fetch_add(p, v, __ATOMIC_RELAXED, __HIP_MEMORY_SCOPE_AGENT); }
__device__ __forceinline__ unsigned xb_xcc_id() { return (unsigned)__builtin_amdgcn_s_getreg((3 << 11) | 20) & 0xFu; }
#define XB_SPIN(cond, bar) do { unsigned _sp = 0; while (cond) { __builtin_amdgcn_s_sleep(1); \
    if ((++_sp & 255u) == 0u) { if (xb_ld(&(bar)[XB_TMO])) break; if (_sp > XB_SPIN_CAP) { atomicAdd(&(bar)[XB_TMO], 1u); break; } } } } while (0)
struct XcdBarrier { unsigned* bar; unsigned x; volatile LAS unsigned* st; };
__device__ __forceinline__ void xcd_barrier_complete(unsigned* bar, unsigned x, unsigned& nloc, unsigned& nx) {
    const unsigned G = gridDim.x * gridDim.y * gridDim.z;
    unsigned sum, cnt, mine, sp = 0u;
    for (;;) {
        sum = 0u; cnt = 0u; mine = 0u;
#pragma unroll
        for (unsigned j = 0; j < 16; ++j) { const unsigned c = xb_ld(&bar[XB_XCNT(j)]); sum += c; cnt += (c > 0u) ? 1u : 0u; mine = (j == x) ? c : mine; }
        if (sum == G) break;
        __builtin_amdgcn_s_sleep(1);
        if ((++sp & 255u) == 0u) { if (xb_ld(&bar[XB_TMO])) break; if (sp > XB_SPIN_CAP) { atomicAdd(&bar[XB_TMO], 1u); break; } }
    }
    nloc = mine > 0u ? mine : 1u; nx = cnt > 0u ? cnt : 1u;
}
__device__ __forceinline__ void xcd_barrier(const XcdBarrier& b, bool leader_thread) {
    asm volatile("s_waitcnt vmcnt(0)" ::: "memory");
    __syncthreads();
    if (leader_thread) {
        unsigned* bar = b.bar;
        __builtin_amdgcn_s_waitcnt(0);
        unsigned nloc = b.st[0], nx = b.st[1];
        if (nloc == 0u) { xcd_barrier_complete(bar, b.x, nloc, nx); b.st[0] = nloc; b.st[1] = nx; }
        const unsigned old = xb_add(&bar[XB_XSUB(b.x)], 1u);
        const unsigned gen = old / nloc;
        if (old + 1u == (gen + 1u) * nloc) {
            __builtin_amdgcn_fence(__ATOMIC_RELEASE, "agent");
            asm volatile("s_waitcnt vmcnt(0)" ::: "memory");
            const unsigned og = xb_add(&bar[XB_TOP], 1u);
            const unsigned tg = og / nx;
            if (og + 1u == (tg + 1u) * nx) xb_add(&bar[XB_TOPGEN], 1u);
            else XB_SPIN(xb_ld(&bar[XB_TOPGEN]) == tg, bar);
            __builtin_amdgcn_fence(__ATOMIC_ACQUIRE, "agent");
            xb_add(&bar[XB_XGEN(b.x)], 1u);
            asm volatile("s_waitcnt vmcnt(0)" ::: "memory");
        } else {
            XB_SPIN(xb_ld(&bar[XB_XGEN(b.x)]) == gen, bar);
            __builtin_amdgcn_fence(__ATOMIC_ACQUIRE, "agent");
            asm volatile("s_waitcnt vmcnt(0)" ::: "memory");
        }
    }
    __syncthreads();
}

struct Args { const float* in[19]; float* out; unsigned char* ws; int ph_lo, ph_hi; };
enum { I_X = 0, I_NMIX, I_WIN, I_BFORGET, I_BGATE, I_QKNA, I_MLAQN, I_MLAKVN, I_WQUP, I_WKVUP, I_QKNBN, I_QKNBR, I_QKNC, I_RELB, I_WBR, I_WOUT, I_NFFN, I_WFF1, I_WFF2 };
constexpr int LDS_BYTES = 147456, LDS_BARST = 147456 - 64;
constexpr size_t WS_BAR = 65536, CTL_ZERO_BYTES = 131072;

struct ConvSrc { const float *win, *nmix, *wqup, *mlaq, *wkvup, *mlakv, *wbr, *wout, *wff1, *nffn, *wff2; };
constexpr int CV_I0 = 16 * 216, CV_I1 = CV_I0 + 6 * 24, CV_I2 = CV_I1 + 4 * 32, CV_I3 = CV_I2 + 3 * 256, CV_I4 = CV_I3 + 512, CV_I5 = CV_I4 + 2048, CV_I6 = CV_I5 + 2048;
constexpr int CV_TICKETS = (CV_I6 + 7) / 8;
constexpr size_t WSET = 365 * MiB;
static_assert(WS_WIN + WSET >= WS_END, "second weight set above the activations");
__device__ __forceinline__ ConvSrc conv_src(const Args& a, int l) {
    ConvSrc c; c.win = a.in[I_WIN] + (size_t)l * 1024 * WIN_SRC; c.nmix = a.in[I_NMIX] + l * 1024; c.wqup = a.in[I_WQUP] + (size_t)l * 384 * 768; c.mlaq = a.in[I_MLAQN] + l * 384;
    c.wkvup = a.in[I_WKVUP] + (size_t)l * 256 * 1024; c.mlakv = a.in[I_MLAKVN] + l * 256; c.wbr = a.in[I_WBR] + (size_t)l * 3 * 512 * 1024; c.wout = a.in[I_WOUT] + (size_t)l * 1024 * 1024;
    c.wff1 = a.in[I_WFF1] + (size_t)l * 1024 * 4096; c.nffn = a.in[I_NFFN] + l * 1024; c.wff2 = a.in[I_WFF2] + (size_t)l * 4096 * 1024; return c;
}
__device__ __forceinline__ void conv_ticket(const ConvSrc& c, unsigned char* wd0, int ticket, LAS unsigned char* lds, int wave) {
    size_t z_ = 0; asm volatile("" : "+s"(z_)); unsigned char* wd = wd0 + z_;
    const int lane = lane_id_v(); LAS float* scr = (LAS float*)(lds + wave * 9216); const int it = 8 * ticket + wave;
    if (it < CV_I0) conv_item(c.win, 1024, WIN_SRC, WIN_N, c.nmix, (bf16*)(wd + WS_WIN), 0, it, scr, lane);
    else if (it < CV_I1) conv_item(c.wqup, 384, 768, 768, c.mlaq, (bf16*)(wd + WS_WQUP), 1, it - CV_I0, scr, lane);
    else if (it < CV_I2) conv_item(c.wkvup, 256, 1024, 1024, c.mlakv, (bf16*)(wd + WS_WKVUP), 2, it - CV_I1, scr, lane);
    else if (it < CV_I3) { const int r = it - CV_I2, z = r >> 8; conv_item(c.wbr + (size_t)z * 512 * 1024, 512, 1024, 1024, nullptr, (bf16*)(wd + WS_WBR) + (size_t)z * 1024 * 512, 3, r & 255, scr, lane); }
    else if (it < CV_I4) conv_item(c.wout, 1024, 1024, 1024, nullptr, (bf16*)(wd + WS_WOUT), 3, it - CV_I3, scr, lane);
    else if (it < CV_I5) conv_item(c.wff1, 1024, 4096, 4096, c.nffn, (bf16*)(wd + WS_WFF1), 3, it - CV_I4, scr, lane);
    else if (it < CV_I6) conv_item(c.wff2, 4096, 1024, 1024, nullptr, (bf16*)(wd + WS_WFF2), 3, it - CV_I5, scr, lane);
}

__global__ void __launch_bounds__(512, 2) fwd_kernel(Args a) {
    extern __shared__ __attribute__((aligned(16))) unsigned char lds_raw[];
    LAS unsigned char* lds = (LAS unsigned char*)lds_raw;
    cg::grid_group grid = cg::this_grid();
    const int G = gridDim.x;
    const int wave0 = __builtin_amdgcn_readfirstlane(threadIdx.x >> 6);
    const int lo = a.ph_lo, hi = a.ph_hi;
    XcdBarrier xbar; xbar.bar = (unsigned*)(a.ws + WS_BAR); xbar.x = xb_xcc_id(); xbar.st = (volatile LAS unsigned*)(lds + LDS_BARST);
    { const int t0 = wave0 * 64 + lane_id_v(); if (t0 < 2) xbar.st[t0] = 0u; __syncthreads(); if (t0 == 0) (void)xb_add(&xbar.bar[XB_XCNT(xbar.x)], 1u); }
#ifndef PROBE_DUP
#define PROBE_DUP -1
#endif
#ifndef PROBE_XSYNC
#define PROBE_XSYNC 0
#endif
#ifndef PH_MASK
#define PH_MASK 255
#endif
#define IN(k) (((PH_MASK >> ((k) & 7)) & 1) && lo <= (k) && (k) < hi)
#define SEAM(k) do { if (IN(k) && IN((k) + 1)) { if (lo < 0) grid.sync(); xcd_barrier(xbar, wave0 * 64 + lane_id_v() == 0); for (int x_ = 0; x_ < PROBE_XSYNC; ++x_) xcd_barrier(xbar, wave0 * 64 + lane_id_v() == 0); } } while (0)
#define PHASE_BEGIN size_t zo_ = 0; asm volatile("" : "+s"(zo_)); unsigned char* ws = a.ws + zo_;     int tid = wave0 * 64 + lane_id_v(); asm volatile("" : "+v"(tid)); \
    const int lane = tid & 63, wave = __builtin_amdgcn_readfirstlane(tid >> 6); (void)lane; (void)wave; \
    float* X = a.out; bf16* XB = (bf16*)(ws + WS_XB); unsigned char* wsw = ws + (size_t)(l & 1) * WSET; (void)wsw; float* ssqx = (float*)(ws + WS_SSQX); float* ssqd = (float*)(ws + WS_SSQD); float* LF = (float*)(ws + WS_LF); float* CUM = (float*)(ws + WS_CUM); float* ROPE = (float*)(ws + WS_ROPE); \
    (void)X; (void)XB; (void)ssqx; (void)ssqd; (void)LF; (void)CUM; (void)ROPE;
    for (int l = 0; l < NLAYER; ++l) {
        const int pb = 8 * l;
        for (int rep_ = 0; rep_ < ((PROBE_DUP == 0) ? 2 : 1); ++rep_) if (l == 0 && IN(pb + 0)) { if (rep_) xcd_barrier(xbar, wave0 * 64 + lane_id_v() == 0); PHASE_BEGIN
            const int gw = blockIdx.x * 8 + wave, NGW = G * 8;
            if (l == 0) {
                for (int i = blockIdx.x * 512 + tid; i < SEQ * 16; i += G * 512) { const int pos = i >> 4, k = i & 15;
                    const float inv = exp2f(-(float)k * (13.287712379549449f / 16.0f)); const float ang = (float)pos * inv;
                    const double rev = (double)ang * 0.15915494309189535; const float fr = (float)(rev - rint(rev));
                    ROPE[pos * 32 + k] = __builtin_amdgcn_cosf(fr); ROPE[pos * 32 + 16 + k] = __builtin_amdgcn_sinf(fr); }
                for (int m = gw; m < MTOK; m += NGW) { const f32x4* xr = (const f32x4*)(a.in[I_X] + (size_t)m * 1024) + lane; float s = 0.f;
#pragma unroll
                    for (int j = 0; j < 4; ++j) { const f32x4 v = xr[64 * j]; s += sq4(v);
                        u32x2 o; o.x = pk2(v[0], v[1]); o.y = pk2(v[2], v[3]); ((u32x2*)(XB + (size_t)m * 1024))[lane + 64 * j] = o; }
#pragma unroll
                    for (int o = 1; o < 64; o <<= 1) s += bperm(lane ^ o, s);
                    if (lane < 16) ssqx[(size_t)m * 16 + lane] = (lane == 0) ? s : 0.f; }
            }
            { const ConvSrc cs = conv_src(a, 0); for (int tk_ = blockIdx.x; tk_ < CV_TICKETS; tk_ += G) conv_ticket(cs, ws, tk_, lds, wave); }
        }
        if (l == 0) SEAM(pb + 0);
        for (int rep_ = 0; rep_ < ((PROBE_DUP == 1) ? 2 : 1); ++rep_) if (IN(pb + 1)) { if (rep_) xcd_barrier(xbar, wave0 * 64 + lane_id_v() == 0); PHASE_BEGIN
            pg8::Gemm g{XB, (const bf16*)(wsw + WS_WIN), MTOK, WIN_N, 1024, 0, 0}; pg8::StaticOrder S; S.init(MTOK, WIN_N, G, (int)blockIdx.x);
            stage_rstd(lds, S, ssqx, a.in[I_BGATE] + l * 3072, tid);
            EpiWin E{(const LAS float*)(lds + SPARE_RS), (bf16*)(ws + WS_QA), (bf16*)(ws + WS_G), (bf16*)(ws + WS_QD), (bf16*)(ws + WS_KVD), (bf16*)(ws + WS_KR), LF, ssqd,
                     a.in[I_QKNA] + l * 128, a.in[I_QKNC] + l * 128, a.in[I_QKNBR] + l * 64, a.in[I_BGATE] + l * 3072, a.in[I_BFORGET] + l * 8, ROPE};
            pg8::gemm_phase<EpiWin, pg8::StaticOrder, true, true>(lds, g, S, E, wave0);
        }
        SEAM(pb + 1);
        for (int rep_ = 0; rep_ < ((PROBE_DUP == 2) ? 2 : 1); ++rep_) if (IN(pb + 2)) { if (rep_) xcd_barrier(xbar, wave0 * 64 + lane_id_v() == 0); PHASE_BEGIN
            const int sb_ = (G >= 256) ? (int)blockIdx.x - (G - 64) : (int)blockIdx.x;
            if (sb_ >= 0 && sb_ < 64 && wave == 0) { const int bh = sb_, b = bh >> 3, h = bh & 7;
                const float* lf = LF + ((size_t)b * SEQ + lane * 32) * 8 + h; float tot = 0.f;
                for (int i = 0; i < 32; ++i) tot += lf[i * 8];
                float inc = tot;
#pragma unroll
                for (int off = 1; off < 64; off <<= 1) { const float t = bperm(lane - off, inc); if (lane >= off) inc += t; }
                float run = inc - tot; float* co = CUM + (size_t)bh * SEQ + lane * 32;
                for (int i = 0; i < 32; ++i) { run += lf[i * 8]; co[i] = run; } }
            { pg8::Gemm g{(const bf16*)(ws + WS_QD), (const bf16*)(wsw + WS_WQUP), MTOK, 768, 384, 0, 0}; pg8::StaticOrder S; S.init(MTOK, 768, G, (int)blockIdx.x);
              EpiQup E{ssqd, (bf16*)(ws + WS_QB), a.in[I_QKNBN] + l * 128, a.in[I_QKNBR] + l * 64, ROPE};
              pg8::gemm_phase<EpiQup, pg8::StaticOrder, true, true>(lds, g, S, E, wave0); }
            { pg8::Gemm g{(const bf16*)(ws + WS_KVD), (const bf16*)(wsw + WS_WKVUP), MTOK, 1024, 256, 0, 0}; pg8::StaticOrder S; S.init(MTOK, 1024, G, (int)blockIdx.x);
              EpiKvup E{ssqd, (bf16*)(ws + WS_KBN), (bf16*)(ws + WS_VB), a.in[I_QKNBN] + l * 128};
              pg8::gemm_phase<EpiKvup, pg8::StaticOrder, true, true>(lds, g, S, E, wave0); }
            if (l + 1 < NLAYER && rep_ == 0) {
                const ConvSrc cs = conv_src(a, l + 1); unsigned char* wd = ws + (size_t)((l + 1) & 1) * WSET; unsigned* cq = (unsigned*)(ws + WS_CTL) + 16 * l + 8;
                LAS int* tkc = (LAS int*)(lds + 131072);
                for (;;) { if (tid == 0) tkc[0] = (int)atomicAdd(cq, 1u);
                    __syncthreads(); const int ti = tkc[0]; __syncthreads();
                    if (ti >= CV_TICKETS) break;
                    conv_ticket(cs, wd, ti, lds, wave); }
            }
        }
        SEAM(pb + 2);
        for (int rep_ = 0; rep_ < ((PROBE_DUP == 3) ? 2 : 1); ++rep_) if (IN(pb + 3)) { if (rep_) xcd_barrier(xbar, wave0 * 64 + lane_id_v() == 0); PHASE_BEGIN
            att::P p{(const bf16*)(ws + WS_QA), (const bf16*)(ws + WS_KA), (const bf16*)(ws + WS_VA), (const bf16*)(ws + WS_QB), (const bf16*)(ws + WS_KBN), (const bf16*)(ws + WS_KR), (const bf16*)(ws + WS_VB),
                     (const bf16*)(ws + WS_QC), (const bf16*)(ws + WS_KC), (const bf16*)(ws + WS_VC), CUM, a.in[I_RELB] + l * 8 * 513,
                     (bf16*)(ws + WS_Y), (bf16*)(ws + WS_Y + 16 * MiB), (bf16*)(ws + WS_Y + 32 * MiB)};
            att::phase(p, lds, (unsigned*)(ws + WS_CTL) + 16 * l + 4 * rep_, wave0, tid);
        }
        SEAM(pb + 3);
        for (int rep_ = 0; rep_ < ((PROBE_DUP == 4) ? 2 : 1); ++rep_) if (IN(pb + 4)) { if (rep_) xcd_barrier(xbar, wave0 * 64 + lane_id_v() == 0); PHASE_BEGIN
            pg8::Gemm g{(const bf16*)(ws + WS_Y), (const bf16*)(wsw + WS_WBR), MTOK, 1024, 512, (size_t)MTOK * 512 * 2, (size_t)1024 * 512 * 2}; pg8::StaticOrder S; S.init(MTOK, 1024, G, (int)blockIdx.x, 3);
            EpiMerge E{(const bf16*)(ws + WS_G), (bf16*)(ws + WS_MG)};
            pg8::gemm_phase<EpiMerge, pg8::StaticOrder, true, true>(lds, g, S, E, wave0);
        }
        SEAM(pb + 4);
        for (int rep_ = 0; rep_ < ((PROBE_DUP == 5) ? 2 : 1); ++rep_) if (IN(pb + 5)) { if (rep_) xcd_barrier(xbar, wave0 * 64 + lane_id_v() == 0); PHASE_BEGIN
            pg8::Gemm g{(const bf16*)(ws + WS_MG), (const bf16*)(wsw + WS_WOUT), MTOK, 1024, 1024, 0, 0}; pg8::StaticOrder S; S.init(MTOK, 1024, G, (int)blockIdx.x);
            EpiRes E{l == 0 ? a.in[I_X] : (const float*)X, X, XB, ssqx, 1};
            pg8::gemm_phase<EpiRes, pg8::StaticOrder, true, true>(lds, g, S, E, wave0);
        }
        SEAM(pb + 5);
        for (int rep_ = 0; rep_ < ((PROBE_DUP == 6) ? 2 : 1); ++rep_) if (IN(pb + 6)) { if (rep_) xcd_barrier(xbar, wave0 * 64 + lane_id_v() == 0); PHASE_BEGIN
            pg8::Gemm g{XB, (const bf16*)(wsw + WS_WFF1), MTOK, 4096, 1024, 0, 0}; pg8::StaticOrder S; S.init(MTOK, 4096, G, (int)blockIdx.x);
            stage_rstd(lds, S, ssqx, nullptr, tid);
            EpiFF1 E{(const LAS float*)(lds + SPARE_RS), (bf16*)(ws + WS_H)};
            pg8::gemm_phase<EpiFF1, pg8::StaticOrder, true, true>(lds, g, S, E, wave0);
        }
        SEAM(pb + 6);
        for (int rep_ = 0; rep_ < ((PROBE_DUP == 7) ? 2 : 1); ++rep_) if (IN(pb + 7)) { if (rep_) xcd_barrier(xbar, wave0 * 64 + lane_id_v() == 0); PHASE_BEGIN
            pg8::Gemm g{(const bf16*)(ws + WS_H), (const bf16*)(wsw + WS_WFF2), MTOK, 1024, 4096, 0, 0}; pg8::StaticOrder S; S.init(MTOK, 1024, G, (int)blockIdx.x);
            EpiRes E{X, X, XB, ssqx, (l + 1 < NLAYER) ? 1 : 0};
            pg8::gemm_phase<EpiRes, pg8::StaticOrder, true, true>(lds, g, S, E, wave0);
        }
        SEAM(pb + 7);
    }
#undef IN
#undef SEAM
#undef PHASE_BEGIN
}

#ifndef N_LAUNCH_MODE
#define N_LAUNCH_MODE 1
#endif
extern "C" void kernel_launch(void* const* d_in, const int* in_sizes, int n_in, void* d_out, int out_size, void* d_ws, size_t ws_size, hipStream_t stream) {
    static int grid = 0;
    if (grid == 0) {
        int dev = 0, cus = 0, per_cu = 0;
        if (n_in != 19 || out_size != MTOK * DM || ws_size < WS_WFF2 + WSET + 8 * MiB || 0) { fprintf(stderr, "kernel_launch: unexpected shapes (n_in %d out %d ws %zu)\n", n_in, out_size, ws_size); grid = -1; return; }
        (void)hipGetDevice(&dev); (void)hipDeviceGetAttribute(&cus, hipDeviceAttributeMultiprocessorCount, dev);
        (void)hipFuncSetAttribute((const void*)fwd_kernel, hipFuncAttributeMaxDynamicSharedMemorySize, LDS_BYTES);
        (void)hipOccupancyMaxActiveBlocksPerMultiprocessor(&per_cu, (const void*)fwd_kernel, 512, LDS_BYTES);
        if (per_cu < 1) per_cu = 1;
        grid = cus * per_cu;
    }
    if (grid < 0) return;
    if (hipMemsetAsync(d_ws, 0, CTL_ZERO_BYTES, stream) != hipSuccess) { fprintf(stderr, "memset failed\n"); return; }
    Args a{};
    for (int i = 0; i < 19; ++i) a.in[i] = (const float*)d_in[i];
    a.out = (float*)d_out; a.ws = (unsigned char*)d_ws;
    const int nph = 8 * NLAYER;
    for (int li = 0; li < N_LAUNCH_MODE; ++li) {
        a.ph_lo = (N_LAUNCH_MODE == 1) ? 0 : li; a.ph_hi = (N_LAUNCH_MODE == 1) ? nph : li + 1;
        void* args[] = {&a};
        hipError_t e = hipLaunchCooperativeKernel((void*)fwd_kernel, dim3(grid), dim3(512), args, LDS_BYTES, stream);
        if (e != hipSuccess) { fprintf(stderr, "cooperative launch failed: %s (grid %d)\n", hipGetErrorString(e), grid); break; }
    }
}
```

```cpp
#include <hip/hip_runtime.h>
#include <hip/hip_cooperative_groups.h>
#include <cstdio>
#include <cstdint>
namespace cg = cooperative_groups;
__device__ __forceinline__ int lane_id_v() { int l; asm volatile("v_mbcnt_lo_u32_b32 %0, -1, 0\n\tv_mbcnt_hi_u32_b32 %0, -1, %0" : "=v"(l)); return l; }
namespace pg8 {
#define PG8_LAS __attribute__((address_space(3)))
typedef unsigned short bf16_t;
typedef short bf16x8 __attribute__((ext_vector_type(8)));
typedef float f32x4 __attribute__((ext_vector_type(4)));
typedef unsigned u32x4 __attribute__((ext_vector_type(4)));
constexpr int BM = 256, BK = 64, HALF = 128, HTB = HALF * BK * 2, STAGE_BYTES = 8 * HTB, NXCD = 8, WGM = 8;

__host__ __device__ __forceinline__ int lds_byte(int r, int c) { const int st = (r >> 4) * 2 + (c >> 5), rr = r & 15, cc = c & 31, ob = rr * 64 + cc * 2; return st * 1024 + (ob ^ (((ob >> 9) & 1) << 5)); }
__host__ __device__ __forceinline__ void stage_rc(int b, int& R, int& C) { const int st = b / 1024, sb = b % 1024, swz = sb ^ (((sb >> 9) & 1) << 5); R = (st >> 1) * 16 + swz / 64; C = (st & 1) * 32 + (swz % 64) / 2; }
__host__ __device__ __forceinline__ int perm32(int rho) { const int n = rho >> 4, i = rho & 15; return 8 * (i >> 2) + 4 * n + (i & 3); }

struct Unit { int pm, pn, pz, ord; };
struct Gemm { const bf16_t* A; const bf16_t* Bt; int M, N, K; size_t azs, bzs; };

struct StaticOrder {
    int nM, nN, nwg, G, c, NZ;
    __host__ __device__ void init(int M, int N, int G_, int c_, int NZ_ = 1) { nM = M / BM; nN = N / BM; nwg = nM * nN; G = G_; c = c_; NZ = NZ_; }
    __host__ __device__ bool next(int i, Unit& u) const {
        const int t = i / NZ; u.pz = i - t * NZ; u.ord = i;
        const long L = (long)t * G + c; if (L >= nwg) return false;
        int wgid = (int)L; { const int q = nwg / NXCD, r = nwg % NXCD, xcd = wgid % NXCD, off = wgid / NXCD; wgid = (xcd < r ? xcd * (q + 1) : r * (q + 1) + (xcd - r) * q) + off; }
        const int nig = WGM * nN, gid = wgid / nig, fm = gid * WGM, gsz = (nM - fm) < WGM ? (nM - fm) : WGM;
        u.pm = fm + ((wgid % nig) % gsz); u.pn = (wgid % nig) / gsz; return true;
    }
};

template <class Epi, class Sched, bool ALIGN_EPI = false, bool SP2 = false>
__device__ __forceinline__ void gemm_phase(PG8_LAS unsigned char* lds, const Gemm g, const Sched& S, const Epi& E, int wave0) {
    int tid_ = wave0 * 64 + lane_id_v(); asm volatile("" : "+v"(tid_));
    const int tid = tid_, wid = __builtin_amdgcn_readfirstlane(tid >> 6), lane = tid & 63, wr = wid >> 2, wc = wid & 3, fr = lane & 15, fq = lane >> 4;
    const int K = g.K, nt = K / BK;
    size_t zo = 0; asm volatile("" : "+s"(zo));
    const char* gA = (const char*)g.A + zo; const char* gB = (const char*)g.Bt + zo;
    unsigned voffA[2], voffB[2];
#pragma unroll
    for (int i = 0; i < 2; ++i) { int R, C; stage_rc(tid * 16 + i * 8192, R, C); const int Rb = Epi::PERM ? ((R & ~31) + perm32(R & 31)) : R;
        voffA[i] = (unsigned)(R * K + C) * 2u; voffB[i] = (unsigned)(Rb * K + C) * 2u; }
    const size_t kstep = (size_t)(BK * 2);
    const size_t hstep = (size_t)HALF * K * 2;
    const size_t tstep = 2 * hstep;
    const unsigned ldsw = (unsigned)wid * 1024u;
    const int aoff = lds_byte(wr * 64 + fr, fq * 8), boff = lds_byte(wc * 32 + fr, fq * 8);
#define PG8_SA(b, h) (((b) * 2 + (h)) * HTB)
#define PG8_SB(b, h) ((4 + (b) * 2 + (h)) * HTB)
#define PG8_STAGE(bufoff, gbase, voff) do { _Pragma("unroll") for (int _i = 0; _i < 2; ++_i) \
        __builtin_amdgcn_global_load_lds((const unsigned*)((const char*)(gbase) + (voff)[_i]), (PG8_LAS unsigned*)(lds + (bufoff) + ldsw + _i * 8192), 16, 0, 0); } while (0)
#define PG8_LDA(dst, b, h) do { _Pragma("unroll") for (int m = 0; m < 4; ++m) _Pragma("unroll") for (int k = 0; k < 2; ++k) dst[m][k] = *(const PG8_LAS bf16x8*)(lds + PG8_SA(b, h) + aoff + m * 2048 + k * 1024); } while (0)
#define PG8_LDB(dst, b, h) do { _Pragma("unroll") for (int n = 0; n < 2; ++n) _Pragma("unroll") for (int k = 0; k < 2; ++k) dst[n][k] = *(const PG8_LAS bf16x8*)(lds + PG8_SB(b, h) + boff + n * 2048 + k * 1024); } while (0)
#define PG8_MMA(ai, bj, At, Bt) do { __builtin_amdgcn_s_setprio(1); _Pragma("unroll") for (int m = 0; m < 4; ++m) _Pragma("unroll") for (int n = 0; n < 2; ++n) _Pragma("unroll") for (int k = 0; k < 2; ++k) \
        acc[ai][bj][m][n] = __builtin_amdgcn_mfma_f32_16x16x32_bf16(Bt[n][k], At[m][k], acc[ai][bj][m][n], 0, 0, 0); __builtin_amdgcn_s_setprio(0); } while (0)
#define PG8_WAIT_V(n) asm volatile("s_waitcnt vmcnt(" #n ")" ::: "memory")
#define PG8_WAIT_L(n) asm volatile("s_waitcnt lgkmcnt(" #n ")" ::: "memory")
#define PG8_BAR __builtin_amdgcn_s_barrier()
#define PG8_SCHED __builtin_amdgcn_sched_barrier(0)
    Unit cur, nxt; int ui = 0;
    if (!S.next(0, cur)) return;
    f32x4 acc[2][2][4][2];
    if constexpr (Epi::INIT) E.init(acc, cur, wr, wc, fr, fq);
    else
#pragma unroll
    for (int a = 0; a < 2; ++a)
#pragma unroll
        for (int b = 0; b < 2; ++b)
#pragma unroll
            for (int m = 0; m < 4; ++m)
#pragma unroll
                for (int n = 0; n < 2; ++n) acc[a][b][m][n] = (f32x4){0.f, 0.f, 0.f, 0.f};
    bf16x8 At[4][2], B0[2][2], B1[2][2];
    const char* cA = gA + (size_t)cur.pm * tstep + (size_t)cur.pz * g.azs; const char* cB = gB + (size_t)cur.pn * tstep + (size_t)cur.pz * g.bzs;
    if constexpr (SP2) {
        PG8_STAGE(PG8_SB(0, 0), cB, voffB); PG8_STAGE(PG8_SB(0, 1), cB + hstep, voffB); PG8_STAGE(PG8_SA(0, 0), cA, voffA); PG8_STAGE(PG8_SA(0, 1), cA + hstep, voffA);
        if (wr == 1) PG8_BAR;
        PG8_WAIT_V(2); PG8_BAR;
        PG8_STAGE(PG8_SB(1, 0), cB + kstep, voffB); PG8_STAGE(PG8_SA(1, 0), cA + kstep, voffA); PG8_STAGE(PG8_SB(1, 1), cB + hstep + kstep, voffB);
        PG8_WAIT_V(6); PG8_BAR;
    } else {
        PG8_STAGE(PG8_SB(0, 0), cB, voffB); PG8_STAGE(PG8_SA(0, 0), cA, voffA); PG8_STAGE(PG8_SB(0, 1), cB + hstep, voffB); PG8_STAGE(PG8_SA(0, 1), cA + hstep, voffA);
        if (wr == 1) PG8_BAR;
        PG8_WAIT_V(4); PG8_BAR;
        PG8_STAGE(PG8_SB(1, 0), cB + kstep, voffB); PG8_STAGE(PG8_SA(1, 0), cA + kstep, voffA); PG8_STAGE(PG8_SB(1, 1), cB + hstep + kstep, voffB);
        PG8_WAIT_V(6); PG8_BAR;
    }
    for (;;) {
        const bool has_next = S.next(ui + 1, nxt);
        const char* nA = has_next ? gA + (size_t)nxt.pm * tstep + (size_t)nxt.pz * g.azs : cA; const char* nB = has_next ? gB + (size_t)nxt.pn * tstep + (size_t)nxt.pz * g.bzs : cB;
        for (int t = 0; t < nt; t += 2) {
            const bool last = (t == nt - 2);
            const char* a1 = cA + (size_t)(t + 1) * kstep;
            const char* a2 = last ? nA : cA + (size_t)(t + 2) * kstep; const char* b2 = last ? nB : cB + (size_t)(t + 2) * kstep;
            const char* a3 = a2 + kstep; const char* b3 = b2 + kstep;
            if constexpr (SP2) {
            PG8_LDB(B0, 0, 0); PG8_LDB(B1, 0, 1); PG8_SCHED; PG8_LDA(At, 0, 0); PG8_STAGE(PG8_SA(1, 1), a1 + hstep, voffA);
            PG8_WAIT_V(8); PG8_WAIT_L(0); PG8_BAR; PG8_MMA(0, 0, At, B0); PG8_MMA(0, 1, At, B1); PG8_BAR; PG8_SCHED;
            PG8_LDA(At, 0, 1); PG8_STAGE(PG8_SB(0, 0), b2, voffB); PG8_STAGE(PG8_SB(0, 1), b2 + hstep, voffB); PG8_STAGE(PG8_SA(0, 0), a2, voffA);
            PG8_WAIT_V(8); PG8_WAIT_L(0); PG8_BAR; PG8_MMA(1, 0, At, B0); PG8_MMA(1, 1, At, B1); PG8_BAR; PG8_SCHED;
            PG8_LDB(B0, 1, 0); PG8_LDB(B1, 1, 1); PG8_SCHED; PG8_LDA(At, 1, 0); PG8_STAGE(PG8_SA(0, 1), a2 + hstep, voffA);
            PG8_WAIT_V(8); PG8_WAIT_L(0); PG8_BAR; PG8_MMA(0, 0, At, B0); PG8_MMA(0, 1, At, B1); PG8_BAR; PG8_SCHED;
            PG8_LDA(At, 1, 1); PG8_STAGE(PG8_SB(1, 0), b3, voffB); PG8_STAGE(PG8_SB(1, 1), b3 + hstep, voffB); PG8_STAGE(PG8_SA(1, 0), a3, voffA);
            PG8_WAIT_V(8); PG8_WAIT_L(0); PG8_BAR; PG8_MMA(1, 0, At, B0); PG8_MMA(1, 1, At, B1); PG8_BAR; PG8_SCHED;
            } else {
            PG8_LDB(B0, 0, 0); PG8_SCHED; PG8_LDA(At, 0, 0); PG8_STAGE(PG8_SA(1, 1), a1 + hstep, voffA);
            PG8_WAIT_L(8); PG8_BAR; PG8_WAIT_L(0); PG8_MMA(0, 0, At, B0); PG8_BAR; PG8_SCHED;
            PG8_LDB(B1, 0, 1); PG8_STAGE(PG8_SB(0, 0), b2, voffB);
            PG8_BAR; PG8_WAIT_L(0); PG8_MMA(0, 1, At, B1); PG8_BAR;
            PG8_LDA(At, 0, 1); PG8_STAGE(PG8_SA(0, 0), a2, voffA);
            PG8_BAR; PG8_WAIT_L(0); PG8_MMA(1, 0, At, B0); PG8_BAR; PG8_SCHED;
            PG8_STAGE(PG8_SB(0, 1), b2 + hstep, voffB);
            PG8_WAIT_V(6); PG8_BAR; PG8_MMA(1, 1, At, B1); PG8_BAR;
            PG8_LDB(B0, 1, 0); PG8_SCHED; PG8_LDA(At, 1, 0); PG8_STAGE(PG8_SA(0, 1), a2 + hstep, voffA);
            PG8_WAIT_L(8); PG8_BAR; PG8_WAIT_L(0); PG8_MMA(0, 0, At, B0); PG8_BAR; PG8_SCHED;
            PG8_LDB(B1, 1, 1); PG8_STAGE(PG8_SB(1, 0), b3, voffB);
            PG8_BAR; PG8_WAIT_L(0); PG8_MMA(0, 1, At, B1); PG8_BAR;
            PG8_LDA(At, 1, 1); PG8_STAGE(PG8_SA(1, 0), a3, voffA);
            PG8_BAR; PG8_WAIT_L(0); PG8_MMA(1, 0, At, B0); PG8_BAR; PG8_SCHED;
            PG8_STAGE(PG8_SB(1, 1), b3 + hstep, voffB);
            PG8_WAIT_V(6); PG8_BAR; PG8_MMA(1, 1, At, B1); PG8_BAR;
            }
        }
        if constexpr (ALIGN_EPI) { if (wr == 0) PG8_BAR; }
        { int l2_ = lane_id_v(); asm volatile("" : "+v"(l2_)); const int fr_ = l2_ & 15, fq_ = l2_ >> 4;
          E(acc, cur, wr, wc, fr_, fq_); }
        const bool keep_acc = Epi::KEEP && E.keep(cur);
        if (!has_next) break;
        if constexpr (Epi::INIT) E.init(acc, nxt, wr, wc, fr, fq);
        else if (!keep_acc)
#pragma unroll
        for (int a = 0; a < 2; ++a)
#pragma unroll
            for (int b = 0; b < 2; ++b)
#pragma unroll
                for (int m = 0; m < 4; ++m)
#pragma unroll
                    for (int n = 0; n < 2; ++n) acc[a][b][m][n] = (f32x4){0.f, 0.f, 0.f, 0.f};
        cur = nxt; cA = nA; cB = nB; ++ui;
        if constexpr (ALIGN_EPI) { if (wr == 1) PG8_BAR; }
    }
    PG8_WAIT_V(0);
    if constexpr (!ALIGN_EPI) { if (wr == 0) PG8_BAR; }
    PG8_BAR;
#undef PG8_SA
#undef PG8_SB
#undef PG8_STAGE
#undef PG8_LDA
#undef PG8_LDB
#undef PG8_MMA
#undef PG8_WAIT_V
#undef PG8_WAIT_L
#undef PG8_BAR
#undef PG8_SCHED
}
}
constexpr int MTOK = 16384, SEQ = 2048, DM = 1024, NLAYER = 4, DFF = 4096;
constexpr int WIN_SRC = 6824, WIN_N = 6912;
constexpr float EPS = 1e-6f, LOG2E = 1.4426950408889634f;
constexpr float QSCALE64 = 0.125f * LOG2E;
constexpr float QSCALE96 = 0.10206207261596575f * LOG2E;
constexpr size_t MiB = 1u << 20;
constexpr size_t WS_CTL = 0, WS_SSQX = 1 * MiB, WS_SSQD = 2 * MiB, WS_LF = 4 * MiB, WS_CUM = 4 * MiB + 512 * 1024, WS_ROPE = 5 * MiB;
constexpr size_t WS_WIN = 8 * MiB, WS_WQUP = 8 * MiB + 14155776, WS_WKVUP = 23 * MiB - 524288 - 65536 * 2, WS_WBR = 23 * MiB, WS_WOUT = 26 * MiB, WS_WFF1 = 28 * MiB, WS_WFF2 = 36 * MiB;
static_assert(WS_WQUP + 768 * 384 * 2 <= WS_WKVUP && WS_WKVUP + 1024 * 256 * 2 <= WS_WBR, "weight map");
constexpr size_t WS_XB = 44 * MiB, WS_G = 76 * MiB, WS_Y = 172 * MiB, WS_QD = 172 * MiB, WS_KVD = 184 * MiB;
constexpr size_t WS_R1 = 220 * MiB;
constexpr size_t WS_QA = WS_R1, WS_KA = WS_R1 + 16 * MiB, WS_VA = WS_R1 + 32 * MiB, WS_QC = WS_R1 + 48 * MiB, WS_KC = WS_R1 + 64 * MiB, WS_VC = WS_R1 + 80 * MiB;
constexpr size_t WS_QB = WS_R1 + 96 * MiB, WS_KBN = WS_R1 + 120 * MiB, WS_KR = WS_R1 + 136 * MiB, WS_VB = WS_R1 + 137 * MiB, WS_END = WS_R1 + 153 * MiB;
constexpr size_t WS_H = WS_R1, WS_MS = WS_R1, WS_MG = WS_R1 + 64 * MiB;

typedef unsigned short bf16;
typedef float f32x4 __attribute__((ext_vector_type(4)));
typedef float f32x2 __attribute__((ext_vector_type(2)));
typedef float f32x16 __attribute__((ext_vector_type(16)));
typedef unsigned u32x4 __attribute__((ext_vector_type(4)));
typedef unsigned u32x2 __attribute__((ext_vector_type(2)));
typedef short bf16x8 __attribute__((ext_vector_type(8)));
typedef __bf16 bf16x2_t __attribute__((ext_vector_type(2)));
#define LAS __attribute__((address_space(3)))

__device__ __forceinline__ unsigned pk2(float lo, float hi) { f32x2 v = {lo, hi}; bf16x2_t b = __builtin_convertvector(v, bf16x2_t); return __builtin_bit_cast(unsigned, b); }
__device__ __forceinline__ u32x4 pk8(f32x4 a, f32x4 b) { u32x4 w; w.x = pk2(a[0], a[1]); w.y = pk2(a[2], a[3]); w.z = pk2(b[0], b[1]); w.w = pk2(b[2], b[3]); return w; }
__device__ __forceinline__ float bf_lo(unsigned w) { return __uint_as_float(w << 16); }
__device__ __forceinline__ float bf_hi(unsigned w) { return __uint_as_float(w & 0xffff0000u); }
__device__ __forceinline__ float sum4(f32x4 a) { return (a[0] + a[1]) + (a[2] + a[3]); }
__device__ __forceinline__ float sq4(f32x4 a) { return (a[0] * a[0] + a[1] * a[1]) + (a[2] * a[2] + a[3] * a[3]); }
__device__ __forceinline__ float swz16(float v) { return __int_as_float(__builtin_amdgcn_ds_swizzle(__float_as_int(v), 0x401F)); }
__device__ __forceinline__ float half_sum(float m) { auto rr = __builtin_amdgcn_permlane32_swap(__float_as_uint(m), __float_as_uint(m), false, false); return __uint_as_float(rr[0]) + __uint_as_float(rr[1]); }
__device__ __forceinline__ float red_fq(float s) { s += swz16(s); return half_sum(s); }
__device__ __forceinline__ float bperm(int srclane, float v) { return __int_as_float(__builtin_amdgcn_ds_bpermute(srclane << 2, __float_as_int(v))); }
__device__ __forceinline__ float sigmoidf_(float z) { return __builtin_amdgcn_rcpf(1.0f + __builtin_amdgcn_exp2f(-z * LOG2E)); }
__device__ __forceinline__ float logsigmoidf_(float z) { return fminf(z, 0.f) - __logf(1.0f + __expf(-fabsf(z))); }

template <int N4, int STRIDE> __device__ __forceinline__ void row_rstd(float (&rs)[2][4], const float* slots, int row0, float invdim, int fq) {
#pragma unroll
    for (int ai = 0; ai < 2; ++ai)
#pragma unroll
        for (int m = 0; m < 4; ++m) { const f32x4* s = (const f32x4*)(slots + (size_t)(row0 + ai * 128 + m * 16) * STRIDE);
            float t = (fq < N4) ? sum4(s[fq < N4 ? fq : 0]) : 0.f;
            t = red_fq(t);
            rs[ai][m] = rsqrtf(t * invdim + EPS); }
}
__device__ __forceinline__ void rope8(f32x4& v0, f32x4& v1, const float* rope, int pos, int fq) {
    const f32x4* t = (const f32x4*)(rope + (size_t)pos * 32 + 8 * (fq & 1));
    const f32x4 c0 = t[0], c1 = t[1], s0 = t[4], s1 = t[5];
    f32x4 o0, o1;
#pragma unroll
    for (int j = 0; j < 4; ++j) { auto r0 = __builtin_amdgcn_permlane32_swap(__float_as_uint(v0[j]), __float_as_uint(v0[j]), false, false), r1 = __builtin_amdgcn_permlane32_swap(__float_as_uint(v1[j]), __float_as_uint(v1[j]), false, false);
        o0[j] = __uint_as_float(fq < 2 ? r0[1] : r0[0]); o1[j] = __uint_as_float(fq < 2 ? r1[1] : r1[0]); }
    const float sg = (fq < 2) ? -1.f : 1.f;
    v0 = v0 * c0 + sg * (o0 * s0); v1 = v1 * c1 + sg * (o1 * s1);
}


constexpr int SPARE_OFF = 131072, SPARE_RS = SPARE_OFF, SPARE_BG = SPARE_OFF + 7168;
__device__ __forceinline__ void stage_rstd(LAS unsigned char* lds, const pg8::StaticOrder& S, const float* ssq, const float* bgate, int tid) {
    LAS float* rs = (LAS float*)(lds + SPARE_RS); LAS float* bg = (LAS float*)(lds + SPARE_BG);
    for (int e = tid; e < 7 * 256; e += 512) { const int i = e >> 8, r = e & 255; pg8::Unit u;
        if (S.next(i, u)) { const f32x4* sp = (const f32x4*)(ssq + (size_t)(u.pm * 256 + r) * 16); const f32x4 a = sp[0], b = sp[1], c = sp[2], d = sp[3];
            rs[e] = rsqrtf(((sum4(a) + sum4(b)) + (sum4(c) + sum4(d))) * (1.0f / 1024.0f) + EPS);
            if (bgate) bg[e] = (u.pn >= 12 && u.pn < 24) ? bgate[256 * (u.pn - 12) + r] : 0.f; } }
    __syncthreads();
}
__device__ __forceinline__ void row_rstd_lds(float (&rs)[2][4], const LAS float* tab, int ord, int wr, int fr) {
#pragma unroll
    for (int ai = 0; ai < 2; ++ai)
#pragma unroll
        for (int m = 0; m < 4; ++m) rs[ai][m] = tab[ord * 256 + ai * 128 + wr * 64 + m * 16 + fr];
}
typedef const pg8::f32x4 (&AccRef)[2][2][4][2];

struct EpiWin {
    static constexpr bool PERM = true, KEEP = false, INIT = false; __device__ __forceinline__ bool keep(const pg8::Unit&) const { return false; }
    const LAS float* sp; bf16 *QA, *G, *QD, *KVD, *KR; float *LF, *ssqd;
    const float *gna, *gnc, *gnr, *bgate, *bforget, *rope;
    __device__ __forceinline__ void operator()(AccRef acc, const pg8::Unit& u, int wr, int wc, int fr, int fq) const {
        const int row0 = u.pm * 256 + wr * 64 + fr; const int pn = u.pn;
        float rs[2][4]; row_rstd_lds(rs, sp, u.ord, wr, fr);
        if (pn < 12) {
            const int seg = pn >> 1, head = 4 * (pn & 1) + wc; const bool isV = (seg == 2 || seg == 5);
            bf16* out = QA + (size_t)seg * ((size_t)MTOK * 512) + head * 64 + 8 * fq;
            const float* gp = (seg < 3 ? gna : gnc) + ((seg == 1 || seg == 4) ? 64 : 0) + 8 * fq;
            const float post = (seg == 0 || seg == 3) ? QSCALE64 : 1.0f;
            f32x4 g4[2][2];
#pragma unroll
            for (int bj = 0; bj < 2; ++bj)
#pragma unroll
                for (int n = 0; n < 2; ++n) g4[bj][n] = isV ? (f32x4){1.f, 1.f, 1.f, 1.f} : *(const f32x4*)(gp + 32 * bj + 4 * n);
#pragma unroll
            for (int ai = 0; ai < 2; ++ai)
#pragma unroll
                for (int m = 0; m < 4; ++m) {
                    const float r = rs[ai][m]; f32x4 v[2][2]; float ss = 0.f;
#pragma unroll
                    for (int bj = 0; bj < 2; ++bj)
#pragma unroll
                        for (int n = 0; n < 2; ++n) { v[bj][n] = acc[ai][bj][m][n] * r; ss += sq4(v[bj][n]); }
                    float sc = 1.0f;
                    if (!isV) { ss = red_fq(ss); sc = rsqrtf(ss * (1.0f / 64.0f) + EPS) * post; }
                    bf16* rowp = out + (size_t)(row0 + ai * 128 + m * 16) * 512;
#pragma unroll
                    for (int bj = 0; bj < 2; ++bj) *(u32x4*)(rowp + 32 * bj) = pk8(v[bj][0] * sc * g4[bj][0], v[bj][1] * sc * g4[bj][1]);
                }
        } else if (pn < 24) {
            const int col0 = 256 * (pn - 12) + 32 * wc + 8 * fq;
            f32x4 b4[2][2];
#pragma unroll
            for (int bj = 0; bj < 2; ++bj)
#pragma unroll
                for (int n = 0; n < 2; ++n) b4[bj][n] = *(const LAS f32x4*)(sp + 7 * 256 + u.ord * 256 + 32 * wc + 8 * fq + 128 * bj + 4 * n);
#pragma unroll
            for (int ai = 0; ai < 2; ++ai)
#pragma unroll
                for (int m = 0; m < 4; ++m) {
                    const float r = rs[ai][m]; bf16* rowp = G + (size_t)(row0 + ai * 128 + m * 16) * 3072 + col0;
#pragma unroll
                    for (int bj = 0; bj < 2; ++bj) { f32x4 a = acc[ai][bj][m][0] * r + b4[bj][0], b = acc[ai][bj][m][1] * r + b4[bj][1];
#pragma unroll
                        for (int j = 0; j < 4; ++j) { a[j] = sigmoidf_(a[j]); b[j] = sigmoidf_(b[j]); }
                        *(u32x4*)(rowp + 128 * bj) = pk8(a, b); }
                }
        } else {
#pragma unroll
            for (int bj = 0; bj < 2; ++bj) {
                const int cb = 256 * (pn - 24) + 128 * bj + 32 * wc;
                if (cb < 640) {
                    bf16* outp = (cb < 384) ? (QD + cb + 8 * fq) : (KVD + (cb - 384) + 8 * fq); const int ld = (cb < 384) ? 384 : 256;
#pragma unroll
                    for (int ai = 0; ai < 2; ++ai)
#pragma unroll
                        for (int m = 0; m < 4; ++m) { const int row = row0 + ai * 128 + m * 16; const float r = rs[ai][m];
                            const f32x4 a = acc[ai][bj][m][0] * r, b = acc[ai][bj][m][1] * r;
                            *(u32x4*)(outp + (size_t)row * ld) = pk8(a, b);
                            const float ss = red_fq(sq4(a) + sq4(b));
                            if (fq == 0) ssqd[(size_t)row * 32 + (cb >> 5)] = ss; }
                } else if (cb == 640) {
                    const f32x4 g0 = *(const f32x4*)(gnr + 32 + 8 * fq), g1 = *(const f32x4*)(gnr + 32 + 8 * fq + 4);
#pragma unroll
                    for (int ai = 0; ai < 2; ++ai)
#pragma unroll
                        for (int m = 0; m < 4; ++m) { const int row = row0 + ai * 128 + m * 16; const float r = rs[ai][m];
                            f32x4 a = acc[ai][bj][m][0] * r, b = acc[ai][bj][m][1] * r;
                            const float sc = rsqrtf(red_fq(sq4(a) + sq4(b)) * (1.0f / 32.0f) + EPS);
                            a = a * sc * g0; b = b * sc * g1; rope8(a, b, rope, row & (SEQ - 1), fq);
                            *(u32x4*)(KR + (size_t)row * 32 + 8 * fq) = pk8(a, b); }
                } else if (cb == 672) {
                    const f32x4 bf0 = *(const f32x4*)(bforget), bf1 = *(const f32x4*)(bforget + 4);
#pragma unroll
                    for (int ai = 0; ai < 2; ++ai)
#pragma unroll
                        for (int m = 0; m < 4; ++m) { const int row = row0 + ai * 128 + m * 16; const float r = rs[ai][m];
                            f32x4 a = acc[ai][bj][m][0] * r + bf0, b = acc[ai][bj][m][1] * r + bf1;
#pragma unroll
                            for (int j = 0; j < 4; ++j) { a[j] = logsigmoidf_(a[j]); b[j] = logsigmoidf_(b[j]); }
                            if (fq == 0) { *(f32x4*)(LF + (size_t)row * 8) = a; *(f32x4*)(LF + (size_t)row * 8 + 4) = b; } }
                }
            }
        }
    }
};

struct EpiQup {
    static constexpr bool PERM = true, KEEP = false, INIT = false; __device__ __forceinline__ bool keep(const pg8::Unit&) const { return false; }
    const float* ssqd; bf16* QB; const float *gnn, *gnr, *rope;
    __device__ __forceinline__ void operator()(AccRef acc, const pg8::Unit& u, int wr, int wc, int fr, int fq) const {
        const int row0 = u.pm * 256 + wr * 64 + fr; const int pn = u.pn;
        float rs[2][4]; row_rstd<3, 32>(rs, ssqd, row0, 1.0f / 384.0f, fq);
        if (pn < 2) {
            const int head = 4 * pn + wc; f32x4 g4[2][2];
#pragma unroll
            for (int bj = 0; bj < 2; ++bj)
#pragma unroll
                for (int n = 0; n < 2; ++n) g4[bj][n] = *(const f32x4*)(gnn + 32 * bj + 8 * fq + 4 * n);
#pragma unroll
            for (int ai = 0; ai < 2; ++ai)
#pragma unroll
                for (int m = 0; m < 4; ++m) { const float r = rs[ai][m]; f32x4 v[2][2]; float ss = 0.f;
#pragma unroll
                    for (int bj = 0; bj < 2; ++bj)
#pragma unroll
                        for (int n = 0; n < 2; ++n) { v[bj][n] = acc[ai][bj][m][n] * r; ss += sq4(v[bj][n]); }
                    const float sc = rsqrtf(red_fq(ss) * (1.0f / 64.0f) + EPS) * QSCALE96;
                    bf16* rowp = QB + (size_t)(row0 + ai * 128 + m * 16) * 768 + head * 96 + 8 * fq;
#pragma unroll
                    for (int bj = 0; bj < 2; ++bj) *(u32x4*)(rowp + 32 * bj) = pk8(v[bj][0] * sc * g4[bj][0], v[bj][1] * sc * g4[bj][1]); }
        } else {
            const f32x4 g0 = *(const f32x4*)(gnr + 8 * fq), g1 = *(const f32x4*)(gnr + 8 * fq + 4);
#pragma unroll
            for (int ai = 0; ai < 2; ++ai)
#pragma unroll
                for (int m = 0; m < 4; ++m) { const int row = row0 + ai * 128 + m * 16; const float r = rs[ai][m];
#pragma unroll
                    for (int bj = 0; bj < 2; ++bj) { const int head = 4 * bj + wc;
                        f32x4 a = acc[ai][bj][m][0] * r, b = acc[ai][bj][m][1] * r;
                        const float sc = rsqrtf(red_fq(sq4(a) + sq4(b)) * (1.0f / 32.0f) + EPS);
                        a = a * sc * g0; b = b * sc * g1; rope8(a, b, rope, row & (SEQ - 1), fq);
                        *(u32x4*)(QB + (size_t)row * 768 + head * 96 + 64 + 8 * fq) = pk8(a * QSCALE96, b * QSCALE96); } }
        }
    }
};
struct EpiKvup {
    static constexpr bool PERM = true, KEEP = false, INIT = false; __device__ __forceinline__ bool keep(const pg8::Unit&) const { return false; }
    const float* ssqd; bf16 *KBN, *VB; const float* gnn;
    __device__ __forceinline__ void operator()(AccRef acc, const pg8::Unit& u, int wr, int wc, int fr, int fq) const {
        const int row0 = u.pm * 256 + wr * 64 + fr; const int pn = u.pn;
        float rs[2][4]; row_rstd<2, 32>(rs, ssqd + 12, row0, 1.0f / 256.0f, fq);
        if (pn < 2) {
            const int head = 4 * pn + wc; f32x4 g4[2][2];
#pragma unroll
            for (int bj = 0; bj < 2; ++bj)
#pragma unroll
                for (int n = 0; n < 2; ++n) g4[bj][n] = *(const f32x4*)(gnn + 64 + 32 * bj + 8 * fq + 4 * n);
#pragma unroll
            for (int ai = 0; ai < 2; ++ai)
#pragma unroll
                for (int m = 0; m < 4; ++m) { const float r = rs[ai][m]; f32x4 v[2][2]; float ss = 0.f;
#pragma unroll
                    for (int bj = 0; bj < 2; ++bj)
#pragma unroll
                        for (int n = 0; n < 2; ++n) { v[bj][n] = acc[ai][bj][m][n] * r; ss += sq4(v[bj][n]); }
                    const float sc = rsqrtf(red_fq(ss) * (1.0f / 64.0f) + EPS);
                    bf16* rowp = KBN + (size_t)(row0 + ai * 128 + m * 16) * 512 + head * 64 + 8 * fq;
#pragma unroll
                    for (int bj = 0; bj < 2; ++bj) *(u32x4*)(rowp + 32 * bj) = pk8(v[bj][0] * sc * g4[bj][0], v[bj][1] * sc * g4[bj][1]); }
        } else {
            const int col0 = 256 * (pn - 2) + 32 * wc + 8 * fq;
#pragma unroll
            for (int ai = 0; ai < 2; ++ai)
#pragma unroll
                for (int m = 0; m < 4; ++m) { const float r = rs[ai][m]; bf16* rowp = VB + (size_t)(row0 + ai * 128 + m * 16) * 512 + col0;
#pragma unroll
                    for (int bj = 0; bj < 2; ++bj) *(u32x4*)(rowp + 128 * bj) = pk8(acc[ai][bj][m][0] * r, acc[ai][bj][m][1] * r); }
        }
    }
};
typedef pg8::f32x4 (&AccMut)[2][2][4][2];
struct EpiMerge {
    static constexpr bool PERM = true, KEEP = true, INIT = false; __device__ __forceinline__ bool keep(const pg8::Unit& u) const { return u.pz < 2; }
    const bf16* G; bf16* MG;
    __device__ __forceinline__ void operator()(AccMut acc, const pg8::Unit& u, int wr, int wc, int fr, int fq) const {
        const int row0 = u.pm * 256 + wr * 64 + fr; const int col0 = u.pn * 256 + 32 * wc + 8 * fq; const int z = u.pz;
#pragma unroll
        for (int ai = 0; ai < 2; ++ai) {
            u32x4 gn[4][2], gd[4][2];
#pragma unroll
            for (int m = 0; m < 4; ++m)
#pragma unroll
                for (int bj = 0; bj < 2; ++bj) { const bf16* gp = G + (size_t)(row0 + ai * 128 + m * 16) * 3072 + 1024 * z + col0 + 128 * bj;
                    gn[m][bj] = *(const u32x4*)gp; gd[m][bj] = (z < 2) ? *(const u32x4*)(gp + 1024) : (u32x4){0x3f803f80u, 0x3f803f80u, 0x3f803f80u, 0x3f803f80u}; }
#pragma unroll
            for (int m = 0; m < 4; ++m)
#pragma unroll
                for (int bj = 0; bj < 2; ++bj) { const u32x4 n4 = gn[m][bj], d4 = gd[m][bj];
                    f32x4 na = {bf_lo(n4.x), bf_hi(n4.x), bf_lo(n4.y), bf_hi(n4.y)}, nb = {bf_lo(n4.z), bf_hi(n4.z), bf_lo(n4.w), bf_hi(n4.w)};
                    if (z < 2) { const f32x4 da = {bf_lo(d4.x), bf_hi(d4.x), bf_lo(d4.y), bf_hi(d4.y)}, db = {bf_lo(d4.z), bf_hi(d4.z), bf_lo(d4.w), bf_hi(d4.w)};
#pragma unroll
                        for (int j = 0; j < 4; ++j) { na[j] *= __builtin_amdgcn_rcpf(fmaxf(da[j], 1e-30f)); nb[j] *= __builtin_amdgcn_rcpf(fmaxf(db[j], 1e-30f)); } }
                    const f32x4 a = acc[ai][bj][m][0] * na, b = acc[ai][bj][m][1] * nb;
                    if (z < 2) { acc[ai][bj][m][0] = a; acc[ai][bj][m][1] = b; }
                    else *(u32x4*)(MG + (size_t)(row0 + ai * 128 + m * 16) * 1024 + col0 + 128 * bj) = pk8(a, b); }
        }
    }
};
struct EpiRes {
    static constexpr bool PERM = true, KEEP = false, INIT = true; __device__ __forceinline__ bool keep(const pg8::Unit&) const { return false; }
    const float* Xin; float* X; bf16* XB; float* ssqx; int wr_xb;
    __device__ __forceinline__ void init(pg8::f32x4 (&acc)[2][2][4][2], const pg8::Unit& u, int wr, int wc, int fr, int fq) const {
        const int row0 = u.pm * 256 + wr * 64 + fr; const int col0 = u.pn * 256 + 32 * wc + 8 * fq;
#pragma unroll
        for (int ai = 0; ai < 2; ++ai)
#pragma unroll
            for (int m = 0; m < 4; ++m)
#pragma unroll
                for (int bj = 0; bj < 2; ++bj) { const float* xp = Xin + (size_t)(row0 + ai * 128 + m * 16) * 1024 + col0 + 128 * bj; acc[ai][bj][m][0] = *(const f32x4*)xp; acc[ai][bj][m][1] = *(const f32x4*)(xp + 4); }
    }
    __device__ __forceinline__ void operator()(AccRef acc, const pg8::Unit& u, int wr, int wc, int fr, int fq) const {
        const int row0 = u.pm * 256 + wr * 64 + fr; const int col0 = u.pn * 256 + 32 * wc + 8 * fq;
#pragma unroll
        for (int ai = 0; ai < 2; ++ai)
#pragma unroll
            for (int m = 0; m < 4; ++m) { const size_t row = (size_t)(row0 + ai * 128 + m * 16); float ss = 0.f;
#pragma unroll
                for (int bj = 0; bj < 2; ++bj) { float* xp = X + row * 1024 + col0 + 128 * bj;
                    const f32x4 a = acc[ai][bj][m][0], b = acc[ai][bj][m][1];
                    *(f32x4*)xp = a; *(f32x4*)(xp + 4) = b; ss += sq4(a) + sq4(b);
                    if (wr_xb) *(u32x4*)(XB + row * 1024 + col0 + 128 * bj) = pk8(a, b); }
                if (wr_xb) { ss = red_fq(ss);
                    if (fq == 0) ssqx[row * 16 + 4 * u.pn + wc] = ss; } }
    }
};
struct EpiFF1 {
    static constexpr bool PERM = true, KEEP = false, INIT = false; __device__ __forceinline__ bool keep(const pg8::Unit&) const { return false; }
    const LAS float* sp; bf16* H;
    __device__ __forceinline__ void operator()(AccRef acc, const pg8::Unit& u, int wr, int wc, int fr, int fq) const {
        const int row0 = u.pm * 256 + wr * 64 + fr; const int col0 = u.pn * 256 + 32 * wc + 8 * fq;
        float rs[2][4]; row_rstd_lds(rs, sp, u.ord, wr, fr);
#pragma unroll
        for (int ai = 0; ai < 2; ++ai)
#pragma unroll
            for (int m = 0; m < 4; ++m) { const float r = rs[ai][m]; bf16* rowp = H + (size_t)(row0 + ai * 128 + m * 16) * 4096 + col0;
#pragma unroll
                for (int bj = 0; bj < 2; ++bj) { f32x4 a = acc[ai][bj][m][0] * r, b = acc[ai][bj][m][1] * r;
#pragma unroll
                    for (int j = 0; j < 4; ++j) { a[j] = fmaxf(a[j], 0.f); b[j] = fmaxf(b[j], 0.f); }
                    *(u32x4*)(rowp + 128 * bj) = pk8(a * a, b * b); } }
    }
};
namespace att {
constexpr int KOFF = 0, KBUF = 64 * 208, VOFF = 2 * KBUF, VSTR = 192, VBUF = 64 * VSTR, KBOFF = VOFF + 2 * VBUF, RELOFF = KBOFF + 512, TKOFF = RELOFF + 2432, LDS_END = TKOFF + 16;
__device__ __forceinline__ int crow(int r, int hi) { return (r & 3) + 8 * (r >> 2) + 4 * hi; }
typedef short v4i16_t __attribute__((ext_vector_type(4)));
typedef short s16x4 __attribute__((ext_vector_type(4)));
__device__ __forceinline__ s16x4 vtr(const LAS unsigned char* p) { return __builtin_bit_cast(s16x4, __builtin_amdgcn_ds_read_tr16_b64_v4i16((LAS v4i16_t*)p)); }
__device__ __forceinline__ float hmax(float m) { auto rr = __builtin_amdgcn_permlane32_swap(__float_as_uint(m), __float_as_uint(m), false, false); return fmaxf(__uint_as_float(rr[0]), __uint_as_float(rr[1])); }
__device__ __forceinline__ float hsum(float m) { auto rr = __builtin_amdgcn_permlane32_swap(__float_as_uint(m), __float_as_uint(m), false, false); return __uint_as_float(rr[0]) + __uint_as_float(rr[1]); }

struct P { const bf16 *QA, *KA, *VA, *QB, *KBN, *KR, *VB, *QC, *KC, *VC; const float *cum, *relb; bf16 *YA, *YB, *YC; };

template <int TYPE, int ND0, int KSTR> __device__ __forceinline__ void tile(LAS unsigned char* lds, int buf, int t, int w_lo, int w_hi, int n, int qrel, int lane, int r32, int hi,
        const bf16x8 (&qr)[ND0], float& m_run, float& l_run, f32x16& o0, f32x16& o1, f32x16& negm) {
    const LAS unsigned char* kb = lds + KOFF + buf * KBUF + r32 * KSTR + hi * 16;
    bf16x8 ka[ND0], kc[ND0];
#pragma unroll
    for (int d0 = 0; d0 < ND0; ++d0) { ka[d0] = *(const LAS bf16x8*)(kb + d0 * 32); kc[d0] = *(const LAS bf16x8*)(kb + 32 * KSTR + d0 * 32); }
    const LAS unsigned char* vb = lds + VOFF + buf * VBUF + (4 * hi + ((lane & 15) >> 2)) * VSTR + (16 * ((lane >> 4) & 1) + 4 * (lane & 3)) * 2;
    s16x4 vf[4][4];
#pragma unroll
    for (int ks = 0; ks < 4; ++ks) { vf[ks][0] = vtr(vb + (16 * ks) * VSTR); vf[ks][1] = vtr(vb + (16 * ks + 8) * VSTR); vf[ks][2] = vtr(vb + (16 * ks) * VSTR + 64); vf[ks][3] = vtr(vb + (16 * ks + 8) * VSTR + 64); }
    f32x4 kbv[8];
    if (TYPE == 0) { const LAS f32x4* kbi = (const LAS f32x4*)(lds + KBOFF + buf * 256);
#pragma unroll
        for (int g = 0; g < 4; ++g) { kbv[g] = kbi[2 * g + hi]; kbv[4 + g] = kbi[8 + 2 * g + hi]; } }
    asm volatile("" ::: "memory");
    const int rel = n - t;
    f32x16 cin = negm;
    if (TYPE == 2 && rel >= 5) { const float c = ((const LAS float*)(lds + RELOFF))[512];
#pragma unroll
        for (int r = 0; r < 16; ++r) cin[r] += c; }
    f32x16 p0 = cin, p1 = cin;
#pragma unroll
    for (int d0 = 0; d0 < ND0; ++d0) {
        p0 = __builtin_amdgcn_mfma_f32_32x32x16_bf16(ka[d0], qr[d0], p0, 0, 0, 0);
        p1 = __builtin_amdgcn_mfma_f32_32x32x16_bf16(kc[d0], qr[d0], p1, 0, 0, 0);
    }
    if (TYPE == 0) {
#pragma unroll
        for (int g = 0; g < 4; ++g)
#pragma unroll
            for (int j = 0; j < 4; ++j) { p0[4 * g + j] += kbv[g][j]; p1[4 * g + j] += kbv[4 + g][j]; }
        if (t == w_hi) {
#pragma unroll
            for (int r = 0; r < 16; ++r) { const int kr_ = crow(r, hi); if (kr_ > qrel) p0[r] = -1e30f; if (kr_ + 32 > qrel) p1[r] = -1e30f; }
        }
    }
    if (TYPE == 2 && rel < 5) {
        const LAS float* rb = (const LAS float*)(lds + RELOFF) + (qrel + 64 * rel + 256 - 4 * hi - 59);
#pragma unroll
        for (int r = 0; r < 16; ++r) { p0[r] += rb[59 - ((r & 3) + 8 * (r >> 2))]; p1[r] += rb[27 - ((r & 3) + 8 * (r >> 2))]; }
    }
    if (t == w_lo) {
        float mx = fmaxf(p0[0], p1[0]);
#pragma unroll
        for (int r = 1; r < 16; ++r) mx = fmaxf(mx, fmaxf(p0[r], p1[r]));
        mx = hmax(mx); m_run = mx;
#pragma unroll
        for (int r = 0; r < 16; ++r) { p0[r] -= mx; p1[r] -= mx; negm[r] = -mx; }
    }
    float ls = 0.f;
#pragma unroll
    for (int r = 0; r < 16; ++r) { p0[r] = __builtin_amdgcn_exp2f(p0[r]); p1[r] = __builtin_amdgcn_exp2f(p1[r]); ls += p0[r] + p1[r]; }
    const float lrow = hsum(ls);
    if (__builtin_amdgcn_ballot_w64(lrow > 1048576.0f) != 0ull) {
        float pm = fmaxf(p0[0], p1[0]);
#pragma unroll
        for (int r = 1; r < 16; ++r) pm = fmaxf(pm, fmaxf(p0[r], p1[r]));
        pm = hmax(pm);
        const float dl = (lrow > 1048576.0f) ? __builtin_amdgcn_logf(pm) : 0.f;
        const float sc = __builtin_amdgcn_exp2f(-dl);
        m_run += dl; l_run *= sc; ls *= sc;
#pragma unroll
        for (int r = 0; r < 16; ++r) { p0[r] *= sc; p1[r] *= sc; o0[r] *= sc; o1[r] *= sc; negm[r] = -m_run; }
    }
    l_run += ls;
#pragma unroll
    for (int ks = 0; ks < 4; ++ks) {
        u32x4 pw;
        if (ks < 2) { pw.x = pk2(p0[8 * ks], p0[8 * ks + 1]); pw.y = pk2(p0[8 * ks + 2], p0[8 * ks + 3]); pw.z = pk2(p0[8 * ks + 4], p0[8 * ks + 5]); pw.w = pk2(p0[8 * ks + 6], p0[8 * ks + 7]); }
        else { const int k2 = ks - 2; pw.x = pk2(p1[8 * k2], p1[8 * k2 + 1]); pw.y = pk2(p1[8 * k2 + 2], p1[8 * k2 + 3]); pw.z = pk2(p1[8 * k2 + 4], p1[8 * k2 + 5]); pw.w = pk2(p1[8 * k2 + 6], p1[8 * k2 + 7]); }
        const bf16x8 pb = __builtin_bit_cast(bf16x8, pw);
        const bf16x8 va0 = __builtin_shufflevector(vf[ks][0], vf[ks][1], 0, 1, 2, 3, 4, 5, 6, 7), va1 = __builtin_shufflevector(vf[ks][2], vf[ks][3], 0, 1, 2, 3, 4, 5, 6, 7);
        o0 = __builtin_amdgcn_mfma_f32_32x32x16_bf16(va0, pb, o0, 0, 0, 0);
        o1 = __builtin_amdgcn_mfma_f32_32x32x16_bf16(va1, pb, o1, 0, 0, 0);
    }
}

template <int TYPE> __device__ __forceinline__ int unit(const P& p, LAS unsigned char* lds, int b, int h, int qb, int wave0, bool pre, unsigned nx, int G,
        u32x4& kA, u32x4& vA, u32x4& k2A, float& cbA, u32x4& kB, u32x4& vB, u32x4& k2B, float& cbB) {
    constexpr int DQK = (TYPE == 1) ? 96 : 64, ND0 = DQK / 16, KSTR = DQK * 2 + 16;
    int tid_ = wave0 * 64 + lane_id_v(); asm volatile("" : "+v"(tid_));
    const int tid = tid_, lane = tid & 63, r32 = lane & 31, hi = lane >> 5; const int w = __builtin_amdgcn_readfirstlane(tid >> 6);
    const size_t rowbase = (size_t)b * SEQ;
    const bf16* Qp = (TYPE == 0) ? p.QA : (TYPE == 1) ? p.QB : p.QC; const bf16* Kp = (TYPE == 0) ? p.KA : (TYPE == 1) ? p.KBN : p.KC; const bf16* Vp = (TYPE == 0) ? p.VA : (TYPE == 1) ? p.VB : p.VC;
    bf16* Yp = (TYPE == 0) ? p.YA : (TYPE == 1) ? p.YB : p.YC;
    constexpr int QPITCH = (TYPE == 1) ? 768 : 512;
    const int n = 4 * qb + (w >> 1);
    const int u_lo = (TYPE == 2) ? (4 * qb - 8 > 0 ? 4 * qb - 8 : 0) : 0, u_hi = 4 * qb + 3;
    const int w_lo = (TYPE == 2) ? (n - 8 > 0 ? n - 8 : 0) : 0, w_hi = n;
    bf16x8 qr[ND0];
    { const bf16* qrow = Qp + (rowbase + 256 * qb + 32 * w + r32) * QPITCH + h * DQK + 8 * hi;
#pragma unroll
      for (int d0 = 0; d0 < ND0; ++d0) qr[d0] = *(const bf16x8*)(qrow + 16 * d0); }
    if (TYPE == 2) { LAS float* rt = (LAS float*)(lds + RELOFF); for (int i = tid; i < 592; i += 512) rt[i] = p.relb[h * 513 + (i < 512 ? i : 512)] * LOG2E; }
    const int srow = tid >> 3, sch = tid & 7;
    const bf16* kg = Kp + (rowbase + srow) * 512 + h * 64 + sch * 8;
    const bf16* vg = Vp + (rowbase + srow) * 512 + h * 64 + sch * 8;
    const bf16* krg = p.KR + (rowbase + ((tid & 255) >> 2)) * 32 + (tid & 3) * 8;
    const float* cg_ = p.cum + (size_t)(b * 8 + h) * SEQ + (tid & 63);
    LAS int* tk = (LAS int*)(lds + TKOFF);
#define ATT_LOAD(t, S) do { const int tl_ = (t) < u_hi ? (t) : u_hi;     \
        k##S = *(const u32x4*)(kg + (size_t)tl_ * 64 * 512); v##S = *(const u32x4*)(vg + (size_t)tl_ * 64 * 512); \
        if (TYPE == 1) k2##S = *(const u32x4*)(krg + (size_t)tl_ * 64 * 32); if (TYPE == 0) cb##S = cg_[tl_ * 64]; } while (0)
#define ATT_LOAD_NEXT(j, S) do { k##S = *(const u32x4*)(nk + (size_t)(j) * 64 * 512); v##S = *(const u32x4*)(nv + (size_t)(j) * 64 * 512); \
        k2##S = *(const u32x4*)(nkr + (size_t)(j) * 64 * 32); cb##S = ncg[(j) * 64]; } while (0)
#define ATT_STORE(buf, S) do { *(LAS u32x4*)(lds + KOFF + (buf) * KBUF + srow * KSTR + sch * 16) = k##S; *(LAS u32x4*)(lds + VOFF + (buf) * VBUF + srow * VSTR + sch * 16) = v##S; \
        if (TYPE == 1 && tid < 256) *(LAS u32x4*)(lds + KOFF + (buf) * KBUF + (tid >> 2) * KSTR + 128 + (tid & 3) * 16) = k2##S; \
        if (TYPE == 0 && tid < 64) ((LAS float*)(lds + KBOFF + (buf) * 256))[tid] = -cb##S * LOG2E; } while (0)
    float m_run = 0.f, l_run = 0.f; f32x16 o0 = {}, o1 = {};
    f32x16 negm;
#pragma unroll
    for (int r = 0; r < 16; ++r) negm[r] = 0.f;
    if (!pre) { ATT_LOAD(u_lo, A); ATT_LOAD(u_lo + 1, B); }
    ATT_STORE(0, A);
    __syncthreads();
    const int qrel = 32 * (w & 1) + r32;
    int t = u_lo;
    for (; t < u_hi - 1; t += 2) {
        ATT_LOAD(t + 2, A);
        if (t >= w_lo && t <= w_hi) tile<TYPE, ND0, KSTR>(lds, 0, t, w_lo, w_hi, n, qrel, lane, r32, hi, qr, m_run, l_run, o0, o1, negm);
        ATT_STORE(1, B);
        __syncthreads();
        ATT_LOAD(t + 3, B);
        if (t + 1 >= w_lo && t + 1 <= w_hi) tile<TYPE, ND0, KSTR>(lds, 1, t + 1, w_lo, w_hi, n, qrel, lane, r32, hi, qr, m_run, l_run, o0, o1, negm);
        ATT_STORE(0, A);
        if (t == u_lo && tid == 0) tk[0] = G + (int)nx;
        __syncthreads();
    }
    const int inext = tk[0];
    {
        const bool nval = inext < 1536; const int ii = nval ? inext : 0;
        const int nqb = 7 - ii / 192, nrem = ii % 192, nq = nrem / 64, nbh = nrem % 64, nb = nbh >> 3, nh = nbh & 7;
        const int nT = (nq == 0) ? 1 : (nq == 1) ? 0 : 2;
        const int nlo = (nT == 2) ? (4 * nqb - 8 > 0 ? 4 * nqb - 8 : 0) : 0;
        const bf16* nKp = (nT == 0) ? p.KA : (nT == 1) ? p.KBN : p.KC; const bf16* nVp = (nT == 0) ? p.VA : (nT == 1) ? p.VB : p.VC;
        const size_t nrow = (size_t)nb * SEQ + (size_t)nlo * 64;
        const bf16* nk = nKp + (nrow + srow) * 512 + nh * 64 + sch * 8; const bf16* nv = nVp + (nrow + srow) * 512 + nh * 64 + sch * 8;
        const bf16* nkr = p.KR + (nrow + ((tid & 255) >> 2)) * 32 + (tid & 3) * 8; const float* ncg = p.cum + (size_t)(nb * 8 + nh) * SEQ + nlo * 64 + (tid & 63);
        ATT_LOAD_NEXT(0, A);
        if (t >= w_lo && t <= w_hi) tile<TYPE, ND0, KSTR>(lds, 0, t, w_lo, w_hi, n, qrel, lane, r32, hi, qr, m_run, l_run, o0, o1, negm);
        ATT_STORE(1, B);
        __syncthreads();
        ATT_LOAD_NEXT(1, B);
        if (t + 1 >= w_lo && t + 1 <= w_hi) tile<TYPE, ND0, KSTR>(lds, 1, t + 1, w_lo, w_hi, n, qrel, lane, r32, hi, qr, m_run, l_run, o0, o1, negm);
        __syncthreads();
    }
#undef ATT_LOAD
#undef ATT_LOAD_NEXT
#undef ATT_STORE
    const float inv = __builtin_amdgcn_rcpf(hsum(l_run));
    bf16* yrow = Yp + (rowbase + 256 * qb + 32 * w + r32) * 512 + h * 64 + 4 * hi;
#pragma unroll
    for (int g = 0; g < 4; ++g) {
        u32x2 w0, w1; w0.x = pk2(o0[4 * g] * inv, o0[4 * g + 1] * inv); w0.y = pk2(o0[4 * g + 2] * inv, o0[4 * g + 3] * inv);
        w1.x = pk2(o1[4 * g] * inv, o1[4 * g + 1] * inv); w1.y = pk2(o1[4 * g + 2] * inv, o1[4 * g + 3] * inv);
        *(u32x2*)(yrow + 8 * g) = w0; *(u32x2*)(yrow + 32 + 8 * g) = w1;
    }
    return inext;
}

__device__ __forceinline__ void phase(const P& p, LAS unsigned char* lds, unsigned* ctr, int wave0, int tid) {
    const int G = (int)gridDim.x;
    u32x4 kA = {}, vA = {}, k2A = {}, kB = {}, vB = {}, k2B = {}; float cbA = 0.f, cbB = 0.f;
    int i = (int)blockIdx.x; bool pre = false;
    while (i < 1536) {
        unsigned nx = 0u;
        if (tid == 0) nx = atomicAdd(ctr, 1u);
        const int qb = 7 - i / 192, rem = i % 192, ty = rem / 64, bh = rem % 64, b = bh >> 3, h = bh & 7;
        if (ty == 0) i = unit<1>(p, lds, b, h, qb, wave0, pre, nx, G, kA, vA, k2A, cbA, kB, vB, k2B, cbB);
        else if (ty == 1) i = unit<0>(p, lds, b, h, qb, wave0, pre, nx, G, kA, vA, k2A, cbA, kB, vB, k2B, cbB);
        else i = unit<2>(p, lds, b, h, qb, wave0, pre, nx, G, kA, vA, k2A, cbA, kB, vB, k2B, cbB);
        pre = true;
    }
}
}
__device__ __forceinline__ int headperm(int nseg, int pitch, int base) { const int ti = nseg >> 8, ct = nseg & 255, bj = ct >> 7, wc = (ct >> 5) & 3, j = ct & 31; return base + (4 * ti + wc) * pitch + 32 * bj + j; }
__device__ __forceinline__ int src_col(int map, int n) {
    if (map == 0) {
        if (n < 3072) { const int seg = n >> 9; const int base = seg == 0 ? 0 : seg == 1 ? 512 : seg == 2 ? 1024 : seg == 3 ? 2216 : seg == 4 ? 2728 : 3240; return headperm(n & 511, 64, base); }
        if (n < 6144) return 3752 + (n - 3072);
        const int tc = n - 6144;
        if (tc < 384) return 1544 + tc; if (tc < 640) return 1928 + (tc - 384); if (tc < 672) return 2184 + (tc - 640); if (tc < 680) return 1536 + (tc - 672); return -1;
    } else if (map == 1) {
        if (n < 512) return headperm(n, 96, 0);
        const int ct = n - 512, bj = ct >> 7, wc = (ct >> 5) & 3, j = ct & 31; return (4 * bj + wc) * 96 + 64 + j;
    } else if (map == 2) {
        if (n < 512) return headperm(n, 128, 0);
        const int c = n - 512; return (c >> 6) * 128 + 64 + (c & 63);
    }
    return n;
}
__device__ __forceinline__ void conv_item(const float* W, int K, int Nsrc, int Ndst, const float* ksc, bf16* WT, int map, int item, LAS float* scr, int lane) {
    const int nblk = Ndst / 32, kb = item / nblk, nb = item % nblk, k0 = 64 * kb, n0 = 32 * nb;
    const int sc = src_col(map, n0 + (lane & 31));
    float wv[32];
    { const float* wp = W + (size_t)(k0 + (lane >> 5)) * Nsrc + (sc >= 0 ? sc : 0);
#pragma unroll
      for (int i = 0; i < 32; ++i) wv[i] = wp[(size_t)(2 * i) * Nsrc]; }
    if (ksc) {
#pragma unroll
        for (int i = 0; i < 32; ++i) wv[i] *= ksc[k0 + 2 * i + (lane >> 5)];
    }
#pragma unroll
    for (int i = 0; i < 32; ++i) scr[(2 * i + (lane >> 5)) * 33 + (lane & 31)] = (sc >= 0) ? wv[i] : 0.f;
    asm volatile("s_waitcnt lgkmcnt(0)" ::: "memory");
    const int c = lane & 7;
#pragma unroll
    for (int j = 0; j < 4; ++j) { const int n = (lane >> 3) + 8 * j; const LAS float* s = scr + (8 * c) * 33 + n;
        u32x4 o; o.x = pk2(s[0 * 33], s[1 * 33]); o.y = pk2(s[2 * 33], s[3 * 33]); o.z = pk2(s[4 * 33], s[5 * 33]); o.w = pk2(s[6 * 33], s[7 * 33]);
        *(u32x4*)(WT + (size_t)(n0 + n) * K + k0 + 8 * c) = o; }
    asm volatile("s_waitcnt lgkmcnt(0)" ::: "memory");
}


#define XB_TMO      128
#define XB_XCNT(j)  (256  + 64 * (j))
#define XB_XSUB(j)  (1280 + 64 * (j))
#define XB_XGEN(j)  (2304 + 64 * (j))
#define XB_TOP      3328
#define XB_TOPGEN   3392
#define XCD_BAR_WORDS 3456
#define XB_SPIN_CAP (1u << 18)
__device__ __forceinline__ unsigned xb_ld(unsigned* p)              { return __hip_atomic_load(p, __ATOMIC_RELAXED, __HIP_MEMORY_SCOPE_AGENT); }
__device__ __forceinline__ unsigned xb_add(unsigned* p, unsigned v) { return __hip_atomic_fetch_add(p, v, __ATOMIC_RELAXED, __HIP_MEMORY_SCOPE_AGENT); }
__device__ __forceinline__ unsigned xb_xcc_id() { return (unsigned)__builtin_amdgcn_s_getreg((3 << 11) | 20) & 0xFu; }
#define XB_SPIN(cond, bar) do { unsigned _sp = 0; while (cond) { __builtin_amdgcn_s_sleep(1); \
    if ((++_sp & 255u) == 0u) { if (xb_ld(&(bar)[XB_TMO])) break; if (_sp > XB_SPIN_CAP) { atomicAdd(&(bar)[XB_TMO], 1u); break; } } } } while (0)
struct XcdBarrier { unsigned* bar; unsigned x; volatile LAS unsigned* st; };
__device__ __forceinline__ void xcd_barrier_complete(unsigned* bar, unsigned x, unsigned& nloc, unsigned& nx) {
    const unsigned G = gridDim.x * gridDim.y * gridDim.z;
    unsigned sum, cnt, mine, sp = 0u;
    for (;;) {
        sum = 0u; cnt = 0u; mine = 0u;
#pragma unroll
        for (unsigned j = 0; j < 16; ++j) { const unsigned c = xb_ld(&bar[XB_XCNT(j)]); sum += c; cnt += (c > 0u) ? 1u : 0u; mine = (j == x) ? c : mine; }
        if (sum == G) break;
        __builtin_amdgcn_s_sleep(1);
        if ((++sp & 255u) == 0u) { if (xb_ld(&bar[XB_TMO])) break; if (sp > XB_SPIN_CAP) { atomicAdd(&bar[XB_TMO], 1u); break; } }
    }
    nloc = mine > 0u ? mine : 1u; nx = cnt > 0u ? cnt : 1u;
}
__device__ __forceinline__ void xcd_barrier(const XcdBarrier& b, bool leader_thread) {
    asm volatile("s_waitcnt vmcnt(0)" ::: "memory");
    __syncthreads();
    if (leader_thread) {
        unsigned* bar = b.bar;
        __builtin_amdgcn_s_waitcnt(0);
        unsigned nloc = b.st[0], nx = b.st[1];
        if (nloc == 0u) { xcd_barrier_complete(bar, b.x, nloc, nx); b.st[0] = nloc; b.st[1] = nx; }
        const unsigned old = xb_add(&bar[XB_XSUB(b.x)], 1u);
        const unsigned gen = old / nloc;
        if (old + 1u == (gen + 1u) * nloc) {
            __builtin_amdgcn_fence(__ATOMIC_RELEASE, "agent");
            asm volatile("s_waitcnt vmcnt(0)" ::: "memory");
            const unsigned og = xb_add(&bar[XB_TOP], 1u);
            const unsigned tg = og / nx;
            if (og + 1u == (tg + 1u) * nx) xb_add(&bar[XB_TOPGEN], 1u);
            else XB_SPIN(xb_ld(&bar[XB_TOPGEN]) == tg, bar);
            __builtin_amdgcn_fence(__ATOMIC_ACQUIRE, "agent");
            xb_add(&bar[XB_XGEN(b.x)], 1u);
            asm volatile("s_waitcnt vmcnt(0)" ::: "memory");
        } else {
            XB_SPIN(xb_ld(&bar[XB_XGEN(b.x)]) == gen, bar);
            __builtin_amdgcn_fence(__ATOMIC_ACQUIRE, "agent");
            asm volatile("s_waitcnt vmcnt(0)" ::: "memory");
        }
    }
    __syncthreads();
}

struct Args { const float* in[19]; float* out; unsigned char* ws; int ph_lo, ph_hi; };
enum { I_X = 0, I_NMIX, I_WIN, I_BFORGET, I_BGATE, I_QKNA, I_MLAQN, I_MLAKVN, I_WQUP, I_WKVUP, I_QKNBN, I_QKNBR, I_QKNC, I_RELB, I_WBR, I_WOUT, I_NFFN, I_WFF1, I_WFF2 };
constexpr int LDS_BYTES = 147456, LDS_BARST = 147456 - 64;
constexpr size_t WS_BAR = 65536, CTL_ZERO_BYTES = 131072;

struct ConvSrc { const float *win, *nmix, *wqup, *mlaq, *wkvup, *mlakv, *wbr, *wout, *wff1, *nffn, *wff2; };
constexpr int CV_I0 = 16 * 216, CV_I1 = CV_I0 + 6 * 24, CV_I2 = CV_I1 + 4 * 32, CV_I3 = CV_I2 + 3 * 256, CV_I4 = CV_I3 + 512, CV_I5 = CV_I4 + 2048, CV_I6 = CV_I5 + 2048;
constexpr int CV_TICKETS = (CV_I6 + 7) / 8;
constexpr size_t WSET = 365 * MiB;
static_assert(WS_WIN + WSET >= WS_END, "second weight set above the activations");
__device__ __forceinline__ ConvSrc conv_src(const Args& a, int l) {
    ConvSrc c; c.win = a.in[I_WIN] + (size_t)l * 1024 * WIN_SRC; c.nmix = a.in[I_NMIX] + l * 1024; c.wqup = a.in[I_WQUP] + (size_t)l * 384 * 768; c.mlaq = a.in[I_MLAQN] + l * 384;
    c.wkvup = a.in[I_WKVUP] + (size_t)l * 256 * 1024; c.mlakv = a.in[I_MLAKVN] + l * 256; c.wbr = a.in[I_WBR] + (size_t)l * 3 * 512 * 1024; c.wout = a.in[I_WOUT] + (size_t)l * 1024 * 1024;
    c.wff1 = a.in[I_WFF1] + (size_t)l * 1024 * 4096; c.nffn = a.in[I_NFFN] + l * 1024; c.wff2 = a.in[I_WFF2] + (size_t)l * 4096 * 1024; return c;
}
__device__ __forceinline__ void conv_ticket(const ConvSrc& c, unsigned char* wd0, int ticket, LAS unsigned char* lds, int wave) {
    size_t z_ = 0; asm volatile("" : "+s"(z_)); unsigned char* wd = wd0 + z_;
    const int lane = lane_id_v(); LAS float* scr = (LAS float*)(lds + wave * 9216); const int it = 8 * ticket + wave;
    if (it < CV_I0) conv_item(c.win, 1024, WIN_SRC, WIN_N, c.nmix, (bf16*)(wd + WS_WIN), 0, it, scr, lane);
    else if (it < CV_I1) conv_item(c.wqup, 384, 768, 768, c.mlaq, (bf16*)(wd + WS_WQUP), 1, it - CV_I0, scr, lane);
    else if (it < CV_I2) conv_item(c.wkvup, 256, 1024, 1024, c.mlakv, (bf16*)(wd + WS_WKVUP), 2, it - CV_I1, scr, lane);
    else if (it < CV_I3) { const int r = it - CV_I2, z = r >> 8; conv_item(c.wbr + (size_t)z * 512 * 1024, 512, 1024, 1024, nullptr, (bf16*)(wd + WS_WBR) + (size_t)z * 1024 * 512, 3, r & 255, scr, lane); }
    else if (it < CV_I4) conv_item(c.wout, 1024, 1024, 1024, nullptr, (bf16*)(wd + WS_WOUT), 3, it - CV_I3, scr, lane);
    else if (it < CV_I5) conv_item(c.wff1, 1024, 4096, 4096, c.nffn, (bf16*)(wd + WS_WFF1), 3, it - CV_I4, scr, lane);
    else if (it < CV_I6) conv_item(c.wff2, 4096, 1024, 1024, nullptr, (bf16*)(wd + WS_WFF2), 3, it - CV_I5, scr, lane);
}

__global__ void __launch_bounds__(512, 2) fwd_kernel(Args a) {
    extern __shared__ __attribute__((aligned(16))) unsigned char lds_raw[];
    LAS unsigned char* lds = (LAS unsigned char*)lds_raw;
    cg::grid_group grid = cg::this_grid();
    const int G = gridDim.x;
    const int wave0 = __builtin_amdgcn_readfirstlane(threadIdx.x >> 6);
    const int lo = a.ph_lo, hi = a.ph_hi;
    XcdBarrier xbar; xbar.bar = (unsigned*)(a.ws + WS_BAR); xbar.x = xb_xcc_id(); xbar.st = (volatile LAS unsigned*)(lds + LDS_BARST);
    { const int t0 = wave0 * 64 + lane_id_v(); if (t0 < 2) xbar.st[t0] = 0u; __syncthreads(); if (t0 == 0) (void)xb_add(&xbar.bar[XB_XCNT(xbar.x)], 1u); }
#ifndef PROBE_DUP
#define PROBE_DUP -1
#endif
#ifndef PROBE_XSYNC
#define PROBE_XSYNC 0
#endif
#ifndef PH_MASK
#define PH_MASK 255
#endif
#define IN(k) (((PH_MASK >> ((k) & 7)) & 1) && lo <= (k) && (k) < hi)
#define SEAM(k) do { if (IN(k) && IN((k) + 1)) { if (lo < 0) grid.sync(); xcd_barrier(xbar, wave0 * 64 + lane_id_v() == 0); for (int x_ = 0; x_ < PROBE_XSYNC; ++x_) xcd_barrier(xbar, wave0 * 64 + lane_id_v() == 0); } } while (0)
#define PHASE_BEGIN size_t zo_ = 0; asm volatile("" : "+s"(zo_)); unsigned char* ws = a.ws + zo_;     int tid = wave0 * 64 + lane_id_v(); asm volatile("" : "+v"(tid)); \
    const int lane = tid & 63, wave = __builtin_amdgcn_readfirstlane(tid >> 6); (void)lane; (void)wave; \
    float* X = a.out; bf16* XB = (bf16*)(ws + WS_XB); unsigned char* wsw = ws + (size_t)(l & 1) * WSET; (void)wsw; float* ssqx = (float*)(ws + WS_SSQX); float* ssqd = (float*)(ws + WS_SSQD); float* LF = (float*)(ws + WS_LF); float* CUM = (float*)(ws + WS_CUM); float* ROPE = (float*)(ws + WS_ROPE); \
    (void)X; (void)XB; (void)ssqx; (void)ssqd; (void)LF; (void)CUM; (void)ROPE;
    for (int l = 0; l < NLAYER; ++l) {
        const int pb = 8 * l;
        for (int rep_ = 0; rep_ < ((PROBE_DUP == 0) ? 2 : 1); ++rep_) if (l == 0 && IN(pb + 0)) { if (rep_) xcd_barrier(xbar, wave0 * 64 + lane_id_v() == 0); PHASE_BEGIN
            const int gw = blockIdx.x * 8 + wave, NGW = G * 8;
            if (l == 0) {
                for (int i = blockIdx.x * 512 + tid; i < SEQ * 16; i += G * 512) { const int pos = i >> 4, k = i & 15;
                    const float inv = exp2f(-(float)k * (13.287712379549449f / 16.0f)); const float ang = (float)pos * inv;
                    const double rev = (double)ang * 0.15915494309189535; const float fr = (float)(rev - rint(rev));
                    ROPE[pos * 32 + k] = __builtin_amdgcn_cosf(fr); ROPE[pos * 32 + 16 + k] = __builtin_amdgcn_sinf(fr); }
                for (int m0 = gw; m0 < MTOK; m0 += 4 * NGW) {
                    f32x4 v[4][4];
#pragma unroll
                    for (int q = 0; q < 4; ++q) { const int m = (m0 + q * NGW < MTOK) ? m0 + q * NGW : m0; const f32x4* xr = (const f32x4*)(a.in[I_X] + (size_t)m * 1024) + lane;
#pragma unroll
                        for (int j = 0; j < 4; ++j) v[q][j] = xr[64 * j]; }
#pragma unroll
                    for (int q = 0; q < 4; ++q) { const int m = m0 + q * NGW; if (m < MTOK) { float s = 0.f;
#pragma unroll
                        for (int j = 0; j < 4; ++j) { s += sq4(v[q][j]); u32x2 o; o.x = pk2(v[q][j][0], v[q][j][1]); o.y = pk2(v[q][j][2], v[q][j][3]); ((u32x2*)(XB + (size_t)m * 1024))[lane + 64 * j] = o; }
#pragma unroll
                        for (int o = 1; o < 64; o <<= 1) s += bperm(lane ^ o, s);
                        if (lane < 16) ssqx[(size_t)m * 16 + lane] = (lane == 0) ? s : 0.f; } } }
            }
            { const ConvSrc cs = conv_src(a, 0); for (int tk_ = blockIdx.x; tk_ < CV_TICKETS; tk_ += G) conv_ticket(cs, ws, tk_, lds, wave); }
        }
        if (l == 0) SEAM(pb + 0);
        for (int rep_ = 0; rep_ < ((PROBE_DUP == 1) ? 2 : 1); ++rep_) if (IN(pb + 1)) { if (rep_) xcd_barrier(xbar, wave0 * 64 + lane_id_v() == 0); PHASE_BEGIN
            pg8::Gemm g{XB, (const bf16*)(wsw + WS_WIN), MTOK, WIN_N, 1024, 0, 0}; pg8::StaticOrder S; S.init(MTOK, WIN_N, G, (int)blockIdx.x);
            stage_rstd(lds, S, ssqx, a.in[I_BGATE] + l * 3072, tid);
            EpiWin E{(const LAS float*)(lds + SPARE_RS), (bf16*)(ws + WS_QA), (bf16*)(ws + WS_G), (bf16*)(ws + WS_QD), (bf16*)(ws + WS_KVD), (bf16*)(ws + WS_KR), LF, ssqd,
                     a.in[I_QKNA] + l * 128, a.in[I_QKNC] + l * 128, a.in[I_QKNBR] + l * 64, a.in[I_BGATE] + l * 3072, a.in[I_BFORGET] + l * 8, ROPE};
            pg8::gemm_phase<EpiWin, pg8::StaticOrder, true, true>(lds, g, S, E, wave0);
        }
        SEAM(pb + 1);
        for (int rep_ = 0; rep_ < ((PROBE_DUP == 2) ? 2 : 1); ++rep_) if (IN(pb + 2)) { if (rep_) xcd_barrier(xbar, wave0 * 64 + lane_id_v() == 0); PHASE_BEGIN
            const int sb_ = (G >= 256) ? (int)blockIdx.x - (G - 64) : (int)blockIdx.x;
            if (sb_ >= 0 && sb_ < 64 && wave == 0) { const int bh = sb_, b = bh >> 3, h = bh & 7;
                const float* lf = LF + ((size_t)b * SEQ + lane * 32) * 8 + h; float tot = 0.f;
                float lv[32];
#pragma unroll
                for (int i = 0; i < 32; ++i) lv[i] = lf[i * 8];
#pragma unroll
                for (int i = 0; i < 32; ++i) tot += lv[i];
                float inc = tot;
#pragma unroll
                for (int off = 1; off < 64; off <<= 1) { const float t = bperm(lane - off, inc); if (lane >= off) inc += t; }
                float run = inc - tot; f32x4* co = (f32x4*)(CUM + (size_t)bh * SEQ + lane * 32);
#pragma unroll
                for (int i = 0; i < 8; ++i) { f32x4 o; run += lv[4 * i]; o[0] = run; run += lv[4 * i + 1]; o[1] = run; run += lv[4 * i + 2]; o[2] = run; run += lv[4 * i + 3]; o[3] = run; co[i] = o; } }
            { pg8::Gemm g{(const bf16*)(ws + WS_QD), (const bf16*)(wsw + WS_WQUP), MTOK, 768, 384, 0, 0}; pg8::StaticOrder S; S.init(MTOK, 768, G, (int)blockIdx.x);
              EpiQup E{ssqd, (bf16*)(ws + WS_QB), a.in[I_QKNBN] + l * 128, a.in[I_QKNBR] + l * 64, ROPE};
              pg8::gemm_phase<EpiQup, pg8::StaticOrder, true, true>(lds, g, S, E, wave0); }
            { pg8::Gemm g{(const bf16*)(ws + WS_KVD), (const bf16*)(wsw + WS_WKVUP), MTOK, 1024, 256, 0, 0}; pg8::StaticOrder S; S.init(MTOK, 1024, G, (int)blockIdx.x);
              EpiKvup E{ssqd, (bf16*)(ws + WS_KBN), (bf16*)(ws + WS_VB), a.in[I_QKNBN] + l * 128};
              pg8::gemm_phase<EpiKvup, pg8::StaticOrder, true, true>(lds, g, S, E, wave0); }
            if (l + 1 < NLAYER && rep_ == 0) {
                const ConvSrc cs = conv_src(a, l + 1); unsigned char* wd = ws + (size_t)((l + 1) & 1) * WSET; unsigned* cq = (unsigned*)(ws + WS_CTL) + 16 * l + 8;
                LAS int* tkc = (LAS int*)(lds + 131072);
                for (;;) { if (tid == 0) tkc[0] = (int)atomicAdd(cq, 1u);
                    __syncthreads(); const int ti = tkc[0]; __syncthreads();
                    if (ti >= CV_TICKETS) break;
                    conv_ticket(cs, wd, ti, lds, wave); }
            }
        }
        SEAM(pb + 2);
        for (int rep_ = 0; rep_ < ((PROBE_DUP == 3) ? 2 : 1); ++rep_) if (IN(pb + 3)) { if (rep_) xcd_barrier(xbar, wave0 * 64 + lane_id_v() == 0); PHASE_BEGIN
            att::P p{(const bf16*)(ws + WS_QA), (const bf16*)(ws + WS_KA), (const bf16*)(ws + WS_VA), (const bf16*)(ws + WS_QB), (const bf16*)(ws + WS_KBN), (const bf16*)(ws + WS_KR), (const bf16*)(ws + WS_VB),
                     (const bf16*)(ws + WS_QC), (const bf16*)(ws + WS_KC), (const bf16*)(ws + WS_VC), CUM, a.in[I_RELB] + l * 8 * 513,
                     (bf16*)(ws + WS_Y), (bf16*)(ws + WS_Y + 16 * MiB), (bf16*)(ws + WS_Y + 32 * MiB)};
            att::phase(p, lds, (unsigned*)(ws + WS_CTL) + 16 * l + 4 * rep_, wave0, tid);
        }
        SEAM(pb + 3);
        for (int rep_ = 0; rep_ < ((PROBE_DUP == 4) ? 2 : 1); ++rep_) if (IN(pb + 4)) { if (rep_) xcd_barrier(xbar, wave0 * 64 + lane_id_v() == 0); PHASE_BEGIN
            pg8::Gemm g{(const bf16*)(ws + WS_Y), (const bf16*)(wsw + WS_WBR), MTOK, 1024, 512, (size_t)MTOK * 512 * 2, (size_t)1024 * 512 * 2}; pg8::StaticOrder S; S.init(MTOK, 1024, G, (int)blockIdx.x, 3);
            EpiMerge E{(const bf16*)(ws + WS_G), (bf16*)(ws + WS_MG)};
            pg8::gemm_phase<EpiMerge, pg8::StaticOrder, true, true>(lds, g, S, E, wave0);
        }
        SEAM(pb + 4);
        for (int rep_ = 0; rep_ < ((PROBE_DUP == 5) ? 2 : 1); ++rep_) if (IN(pb + 5)) { if (rep_) xcd_barrier(xbar, wave0 * 64 + lane_id_v() == 0); PHASE_BEGIN
            pg8::Gemm g{(const bf16*)(ws + WS_MG), (const bf16*)(wsw + WS_WOUT), MTOK, 1024, 1024, 0, 0}; pg8::StaticOrder S; S.init(MTOK, 1024, G, (int)blockIdx.x);
            EpiRes E{l == 0 ? a.in[I_X] : (const float*)X, X, XB, ssqx, 1};
            pg8::gemm_phase<EpiRes, pg8::StaticOrder, true, true>(lds, g, S, E, wave0);
        }
        SEAM(pb + 5);
        for (int rep_ = 0; rep_ < ((PROBE_DUP == 6) ? 2 : 1); ++rep_) if (IN(pb + 6)) { if (rep_) xcd_barrier(xbar, wave0 * 64 + lane_id_v() == 0); PHASE_BEGIN
            pg8::Gemm g{XB, (const bf16*)(wsw + WS_WFF1), MTOK, 4096, 1024, 0, 0}; pg8::StaticOrder S; S.init(MTOK, 4096, G, (int)blockIdx.x);
            stage_rstd(lds, S, ssqx, nullptr, tid);
            EpiFF1 E{(const LAS float*)(lds + SPARE_RS), (bf16*)(ws + WS_H)};
            pg8::gemm_phase<EpiFF1, pg8::StaticOrder, true, true>(lds, g, S, E, wave0);
        }
        SEAM(pb + 6);
        for (int rep_ = 0; rep_ < ((PROBE_DUP == 7) ? 2 : 1); ++rep_) if (IN(pb + 7)) { if (rep_) xcd_barrier(xbar, wave0 * 64 + lane_id_v() == 0); PHASE_BEGIN
            pg8::Gemm g{(const bf16*)(ws + WS_H), (const bf16*)(wsw + WS_WFF2), MTOK, 1024, 4096, 0, 0}; pg8::StaticOrder S; S.init(MTOK, 1024, G, (int)blockIdx.x);
            EpiRes E{X, X, XB, ssqx, (l + 1 < NLAYER) ? 1 : 0};
            pg8::gemm_phase<EpiRes, pg8::StaticOrder, true, true>(lds, g, S, E, wave0);
        }
        SEAM(pb + 7);
    }
#undef IN
#undef SEAM
#undef PHASE_BEGIN
}

#ifndef N_LAUNCH_MODE
#define N_LAUNCH_MODE 1
#endif
extern "C" void kernel_launch(void* const* d_in, const int* in_sizes, int n_in, void* d_out, int out_size, void* d_ws, size_t ws_size, hipStream_t stream) {
    static int grid = 0;
    if (grid == 0) {
        int dev = 0, cus = 0, per_cu = 0;
        if (n_in != 19 || out_size != MTOK * DM || ws_size < WS_WFF2 + WSET + 8 * MiB || 0) { fprintf(stderr, "kernel_launch: unexpected shapes (n_in %d out %d ws %zu)\n", n_in, out_size, ws_size); grid = -1; return; }
        (void)hipGetDevice(&dev); (void)hipDeviceGetAttribute(&cus, hipDeviceAttributeMultiprocessorCount, dev);
        (void)hipFuncSetAttribute((const void*)fwd_kernel, hipFuncAttributeMaxDynamicSharedMemorySize, LDS_BYTES);
        (void)hipOccupancyMaxActiveBlocksPerMultiprocessor(&per_cu, (const void*)fwd_kernel, 512, LDS_BYTES);
        if (per_cu < 1) per_cu = 1;
        grid = cus * per_cu;
    }
    if (grid < 0) return;
    if (hipMemsetAsync(d_ws, 0, CTL_ZERO_BYTES, stream) != hipSuccess) { fprintf(stderr, "memset failed\n"); return; }
    Args a{};
    for (int i = 0; i < 19; ++i) a.in[i] = (const float*)d_in[i];
    a.out = (float*)d_out; a.ws = (unsigned char*)d_ws;
    const int nph = 8 * NLAYER;
    for (int li = 0; li < N_LAUNCH_MODE; ++li) {
        a.ph_lo = (N_LAUNCH_MODE == 1) ? 0 : li; a.ph_hi = (N_LAUNCH_MODE == 1) ? nph : li + 1;
        void* args[] = {&a};
        hipError_t e = hipLaunchCooperativeKernel((void*)fwd_kernel, dim3(grid), dim3(512), args, LDS_BYTES, stream);
        if (e != hipSuccess) { fprintf(stderr, "cooperative launch failed: %s (grid %d)\n", hipGetErrorString(e), grid); break; }
    }
}
```

```cpp
#include <hip/hip_runtime.h>
#include <hip/hip_cooperative_groups.h>
#include <cstdio>
#include <cstdint>
namespace cg = cooperative_groups;
__device__ __forceinline__ int lane_id_v() { int l; asm volatile("v_mbcnt_lo_u32_b32 %0, -1, 0\n\tv_mbcnt_hi_u32_b32 %0, -1, %0" : "=v"(l)); return l; }
namespace pg8 {
#define PG8_LAS __attribute__((address_space(3)))
typedef unsigned short bf16_t;
typedef short bf16x8 __attribute__((ext_vector_type(8)));
typedef float f32x4 __attribute__((ext_vector_type(4)));
typedef unsigned u32x4 __attribute__((ext_vector_type(4)));
constexpr int BM = 256, BK = 64, HALF = 128, HTB = HALF * BK * 2, STAGE_BYTES = 8 * HTB, NXCD = 8, WGM = 8;

__host__ __device__ __forceinline__ int lds_byte(int r, int c) { const int st = (r >> 4) * 2 + (c >> 5), rr = r & 15, cc = c & 31, ob = rr * 64 + cc * 2; return st * 1024 + (ob ^ (((ob >> 9) & 1) << 5)); }
__host__ __device__ __forceinline__ void stage_rc(int b, int& R, int& C) { const int st = b / 1024, sb = b % 1024, swz = sb ^ (((sb >> 9) & 1) << 5); R = (st >> 1) * 16 + swz / 64; C = (st & 1) * 32 + (swz % 64) / 2; }
__host__ __device__ __forceinline__ int perm32(int rho) { const int n = rho >> 4, i = rho & 15; return 8 * (i >> 2) + 4 * n + (i & 3); }

struct Unit { int pm, pn, pz, ord; };
struct Gemm { const bf16_t* A; const bf16_t* Bt; int M, N, K; size_t azs, bzs; };

struct StaticOrder {
    int nM, nN, nwg, G, c, NZ;
    __host__ __device__ void init(int M, int N, int G_, int c_, int NZ_ = 1) { nM = M / BM; nN = N / BM; nwg = nM * nN; G = G_; c = c_; NZ = NZ_; }
    __host__ __device__ bool next(int i, Unit& u) const {
        const int t = i / NZ; u.pz = i - t * NZ; u.ord = i;
        const long L = (long)t * G + c; if (L >= nwg) return false;
        int wgid = (int)L; { const int q = nwg / NXCD, r = nwg % NXCD, xcd = wgid % NXCD, off = wgid / NXCD; wgid = (xcd < r ? xcd * (q + 1) : r * (q + 1) + (xcd - r) * q) + off; }
        const int nig = WGM * nN, gid = wgid / nig, fm = gid * WGM, gsz = (nM - fm) < WGM ? (nM - fm) : WGM;
        u.pm = fm + ((wgid % nig) % gsz); u.pn = (wgid % nig) / gsz; return true;
    }
};

template <class Epi, class Sched, bool ALIGN_EPI = false, bool SP2 = false>
__device__ __forceinline__ void gemm_phase(PG8_LAS unsigned char* lds, const Gemm g, const Sched& S, const Epi& E, int wave0) {
    int tid_ = wave0 * 64 + lane_id_v(); asm volatile("" : "+v"(tid_));
    const int tid = tid_, wid = __builtin_amdgcn_readfirstlane(tid >> 6), lane = tid & 63, wr = wid >> 2, wc = wid & 3, fr = lane & 15, fq = lane >> 4;
    const int K = g.K, nt = K / BK;
    size_t zo = 0; asm volatile("" : "+s"(zo));
    const char* gA = (const char*)g.A + zo; const char* gB = (const char*)g.Bt + zo;
    unsigned voffA[2], voffB[2];
#pragma unroll
    for (int i = 0; i < 2; ++i) { int R, C; stage_rc(tid * 16 + i * 8192, R, C); const int Rb = Epi::PERM ? ((R & ~31) + perm32(R & 31)) : R;
        voffA[i] = (unsigned)(R * K + C) * 2u; voffB[i] = (unsigned)(Rb * K + C) * 2u; }
    const size_t kstep = (size_t)(BK * 2);
    const size_t hstep = (size_t)HALF * K * 2;
    const size_t tstep = 2 * hstep;
    const unsigned ldsw = (unsigned)wid * 1024u;
    const int aoff = lds_byte(wr * 64 + fr, fq * 8), boff = lds_byte(wc * 32 + fr, fq * 8);
#define PG8_SA(b, h) (((b) * 2 + (h)) * HTB)
#define PG8_SB(b, h) ((4 + (b) * 2 + (h)) * HTB)
#define PG8_STAGE(bufoff, gbase, voff) do { _Pragma("unroll") for (int _i = 0; _i < 2; ++_i) \
        __builtin_amdgcn_global_load_lds((const unsigned*)((const char*)(gbase) + (voff)[_i]), (PG8_LAS unsigned*)(lds + (bufoff) + ldsw + _i * 8192), 16, 0, 0); } while (0)
#define PG8_LDA(dst, b, h) do { _Pragma("unroll") for (int m = 0; m < 4; ++m) _Pragma("unroll") for (int k = 0; k < 2; ++k) dst[m][k] = *(const PG8_LAS bf16x8*)(lds + PG8_SA(b, h) + aoff + m * 2048 + k * 1024); } while (0)
#define PG8_LDB(dst, b, h) do { _Pragma("unroll") for (int n = 0; n < 2; ++n) _Pragma("unroll") for (int k = 0; k < 2; ++k) dst[n][k] = *(const PG8_LAS bf16x8*)(lds + PG8_SB(b, h) + boff + n * 2048 + k * 1024); } while (0)
#define PG8_MMA(ai, bj, At, Bt) do { __builtin_amdgcn_s_setprio(1); _Pragma("unroll") for (int m = 0; m < 4; ++m) _Pragma("unroll") for (int n = 0; n < 2; ++n) _Pragma("unroll") for (int k = 0; k < 2; ++k) \
        acc[ai][bj][m][n] = __builtin_amdgcn_mfma_f32_16x16x32_bf16(Bt[n][k], At[m][k], acc[ai][bj][m][n], 0, 0, 0); __builtin_amdgcn_s_setprio(0); } while (0)
#define PG8_WAIT_V(n) asm volatile("s_waitcnt vmcnt(" #n ")" ::: "memory")
#define PG8_WAIT_L(n) asm volatile("s_waitcnt lgkmcnt(" #n ")" ::: "memory")
#define PG8_BAR __builtin_amdgcn_s_barrier()
#define PG8_SCHED __builtin_amdgcn_sched_barrier(0)
    Unit cur, nxt; int ui = 0;
    if (!S.next(0, cur)) return;
    f32x4 acc[2][2][4][2];
    if constexpr (Epi::INIT) E.init(acc, cur, wr, wc, fr, fq);
    else
#pragma unroll
    for (int a = 0; a < 2; ++a)
#pragma unroll
        for (int b = 0; b < 2; ++b)
#pragma unroll
            for (int m = 0; m < 4; ++m)
#pragma unroll
                for (int n = 0; n < 2; ++n) acc[a][b][m][n] = (f32x4){0.f, 0.f, 0.f, 0.f};
    bf16x8 At[4][2], B0[2][2], B1[2][2];
    const char* cA = gA + (size_t)cur.pm * tstep + (size_t)cur.pz * g.azs; const char* cB = gB + (size_t)cur.pn * tstep + (size_t)cur.pz * g.bzs;
    if constexpr (SP2) {
        PG8_STAGE(PG8_SB(0, 0), cB, voffB); PG8_STAGE(PG8_SB(0, 1), cB + hstep, voffB); PG8_STAGE(PG8_SA(0, 0), cA, voffA); PG8_STAGE(PG8_SA(0, 1), cA + hstep, voffA);
        if (wr == 1) PG8_BAR;
        PG8_WAIT_V(2); PG8_BAR;
        PG8_STAGE(PG8_SB(1, 0), cB + kstep, voffB); PG8_STAGE(PG8_SA(1, 0), cA + kstep, voffA); PG8_STAGE(PG8_SB(1, 1), cB + hstep + kstep, voffB);
        PG8_WAIT_V(6); PG8_BAR;
    } else {
        PG8_STAGE(PG8_SB(0, 0), cB, voffB); PG8_STAGE(PG8_SA(0, 0), cA, voffA); PG8_STAGE(PG8_SB(0, 1), cB + hstep, voffB); PG8_STAGE(PG8_SA(0, 1), cA + hstep, voffA);
        if (wr == 1) PG8_BAR;
        PG8_WAIT_V(4); PG8_BAR;
        PG8_STAGE(PG8_SB(1, 0), cB + kstep, voffB); PG8_STAGE(PG8_SA(1, 0), cA + kstep, voffA); PG8_STAGE(PG8_SB(1, 1), cB + hstep + kstep, voffB);
        PG8_WAIT_V(6); PG8_BAR;
    }
    for (;;) {
        const bool has_next = S.next(ui + 1, nxt);
        const char* nA = has_next ? gA + (size_t)nxt.pm * tstep + (size_t)nxt.pz * g.azs : cA; const char* nB = has_next ? gB + (size_t)nxt.pn * tstep + (size_t)nxt.pz * g.bzs : cB;
        for (int t = 0; t < nt; t += 2) {
            const bool last = (t == nt - 2);
            const char* a1 = cA + (size_t)(t + 1) * kstep;
            const char* a2 = last ? nA : cA + (size_t)(t + 2) * kstep; const char* b2 = last ? nB : cB + (size_t)(t + 2) * kstep;
            const char* a3 = a2 + kstep; const char* b3 = b2 + kstep;
            if constexpr (SP2) {
            PG8_LDB(B0, 0, 0); PG8_LDB(B1, 0, 1); PG8_SCHED; PG8_LDA(At, 0, 0); PG8_STAGE(PG8_SA(1, 1), a1 + hstep, voffA);
            PG8_WAIT_V(8); PG8_WAIT_L(0); PG8_BAR; PG8_MMA(0, 0, At, B0); PG8_MMA(0, 1, At, B1); PG8_BAR; PG8_SCHED;
            PG8_LDA(At, 0, 1); PG8_STAGE(PG8_SB(0, 0), b2, voffB); PG8_STAGE(PG8_SB(0, 1), b2 + hstep, voffB); PG8_STAGE(PG8_SA(0, 0), a2, voffA);
            PG8_WAIT_V(8); PG8_WAIT_L(0); PG8_BAR; PG8_MMA(1, 0, At, B0); PG8_MMA(1, 1, At, B1); PG8_BAR; PG8_SCHED;
            PG8_LDB(B0, 1, 0); PG8_LDB(B1, 1, 1); PG8_SCHED; PG8_LDA(At, 1, 0); PG8_STAGE(PG8_SA(0, 1), a2 + hstep, voffA);
            PG8_WAIT_V(8); PG8_WAIT_L(0); PG8_BAR; PG8_MMA(0, 0, At, B0); PG8_MMA(0, 1, At, B1); PG8_BAR; PG8_SCHED;
            PG8_LDA(At, 1, 1); PG8_STAGE(PG8_SB(1, 0), b3, voffB); PG8_STAGE(PG8_SB(1, 1), b3 + hstep, voffB); PG8_STAGE(PG8_SA(1, 0), a3, voffA);
            PG8_WAIT_V(8); PG8_WAIT_L(0); PG8_BAR; PG8_MMA(1, 0, At, B0); PG8_MMA(1, 1, At, B1); PG8_BAR; PG8_SCHED;
            } else {
            PG8_LDB(B0, 0, 0); PG8_SCHED; PG8_LDA(At, 0, 0); PG8_STAGE(PG8_SA(1, 1), a1 + hstep, voffA);
            PG8_WAIT_L(8); PG8_BAR; PG8_WAIT_L(0); PG8_MMA(0, 0, At, B0); PG8_BAR; PG8_SCHED;
            PG8_LDB(B1, 0, 1); PG8_STAGE(PG8_SB(0, 0), b2, voffB);
            PG8_BAR; PG8_WAIT_L(0); PG8_MMA(0, 1, At, B1); PG8_BAR;
            PG8_LDA(At, 0, 1); PG8_STAGE(PG8_SA(0, 0), a2, voffA);
            PG8_BAR; PG8_WAIT_L(0); PG8_MMA(1, 0, At, B0); PG8_BAR; PG8_SCHED;
            PG8_STAGE(PG8_SB(0, 1), b2 + hstep, voffB);
            PG8_WAIT_V(6); PG8_BAR; PG8_MMA(1, 1, At, B1); PG8_BAR;
            PG8_LDB(B0, 1, 0); PG8_SCHED; PG8_LDA(At, 1, 0); PG8_STAGE(PG8_SA(0, 1), a2 + hstep, voffA);
            PG8_WAIT_L(8); PG8_BAR; PG8_WAIT_L(0); PG8_MMA(0, 0, At, B0); PG8_BAR; PG8_SCHED;
            PG8_LDB(B1, 1, 1); PG8_STAGE(PG8_SB(1, 0), b3, voffB);
            PG8_BAR; PG8_WAIT_L(0); PG8_MMA(0, 1, At, B1); PG8_BAR;
            PG8_LDA(At, 1, 1); PG8_STAGE(PG8_SA(1, 0), a3, voffA);
            PG8_BAR; PG8_WAIT_L(0); PG8_MMA(1, 0, At, B0); PG8_BAR; PG8_SCHED;
            PG8_STAGE(PG8_SB(1, 1), b3 + hstep, voffB);
            PG8_WAIT_V(6); PG8_BAR; PG8_MMA(1, 1, At, B1); PG8_BAR;
            }
        }
        if constexpr (ALIGN_EPI) { if (wr == 0) PG8_BAR; }
        { int l2_ = lane_id_v(); asm volatile("" : "+v"(l2_)); const int fr_ = l2_ & 15, fq_ = l2_ >> 4;
          E(acc, cur, wr, wc, fr_, fq_); }
        const bool keep_acc = Epi::KEEP && E.keep(cur);
        if (!has_next) break;
        if constexpr (Epi::INIT) E.init(acc, nxt, wr, wc, fr, fq);
        else if (!keep_acc)
#pragma unroll
        for (int a = 0; a < 2; ++a)
#pragma unroll
            for (int b = 0; b < 2; ++b)
#pragma unroll
                for (int m = 0; m < 4; ++m)
#pragma unroll
                    for (int n = 0; n < 2; ++n) acc[a][b][m][n] = (f32x4){0.f, 0.f, 0.f, 0.f};
        cur = nxt; cA = nA; cB = nB; ++ui;
        if constexpr (ALIGN_EPI) { if (wr == 1) PG8_BAR; }
    }
    PG8_WAIT_V(0);
    if constexpr (!ALIGN_EPI) { if (wr == 0) PG8_BAR; }
    PG8_BAR;
#undef PG8_SA
#undef PG8_SB
#undef PG8_STAGE
#undef PG8_LDA
#undef PG8_LDB
#undef PG8_MMA
#undef PG8_WAIT_V
#undef PG8_WAIT_L
#undef PG8_BAR
#undef PG8_SCHED
}
}
constexpr int MTOK = 16384, SEQ = 2048, DM = 1024, NLAYER = 4, DFF = 4096;
constexpr int WIN_SRC = 6824, WIN_N = 6912;
constexpr float EPS = 1e-6f, LOG2E = 1.4426950408889634f;
constexpr float QSCALE64 = 0.125f * LOG2E;
constexpr float QSCALE96 = 0.10206207261596575f * LOG2E;
constexpr size_t MiB = 1u << 20;
constexpr size_t WS_CTL = 0, WS_SSQX = 1 * MiB, WS_SSQD = 2 * MiB, WS_LF = 4 * MiB, WS_CUM = 4 * MiB + 512 * 1024, WS_ROPE = 5 * MiB;
constexpr size_t WS_WIN = 8 * MiB, WS_WQUP = 8 * MiB + 14155776, WS_WKVUP = 23 * MiB - 524288 - 65536 * 2, WS_WBR = 23 * MiB, WS_WOUT = 26 * MiB, WS_WFF1 = 28 * MiB, WS_WFF2 = 36 * MiB;
static_assert(WS_WQUP + 768 * 384 * 2 <= WS_WKVUP && WS_WKVUP + 1024 * 256 * 2 <= WS_WBR, "weight map");
constexpr size_t WS_XB = 44 * MiB, WS_G = 76 * MiB, WS_Y = 172 * MiB, WS_QD = 172 * MiB, WS_KVD = 184 * MiB;
constexpr size_t WS_R1 = 220 * MiB;
constexpr size_t WS_QA = WS_R1, WS_KA = WS_R1 + 16 * MiB, WS_VA = WS_R1 + 32 * MiB, WS_QC = WS_R1 + 48 * MiB, WS_KC = WS_R1 + 64 * MiB, WS_VC = WS_R1 + 80 * MiB;
constexpr size_t WS_QB = WS_R1 + 96 * MiB, WS_KBN = WS_R1 + 120 * MiB, WS_KR = WS_R1 + 136 * MiB, WS_VB = WS_R1 + 137 * MiB, WS_END = WS_R1 + 153 * MiB;
constexpr size_t WS_H = WS_R1, WS_MS = WS_R1, WS_MG = WS_R1 + 64 * MiB;

typedef unsigned short bf16;
typedef float f32x4 __attribute__((ext_vector_type(4)));
typedef float f32x2 __attribute__((ext_vector_type(2)));
typedef float f32x16 __attribute__((ext_vector_type(16)));
typedef unsigned u32x4 __attribute__((ext_vector_type(4)));
typedef unsigned u32x2 __attribute__((ext_vector_type(2)));
typedef short bf16x8 __attribute__((ext_vector_type(8)));
typedef __bf16 bf16x2_t __attribute__((ext_vector_type(2)));
#define LAS __attribute__((address_space(3)))

__device__ __forceinline__ unsigned pk2(float lo, float hi) { f32x2 v = {lo, hi}; bf16x2_t b = __builtin_convertvector(v, bf16x2_t); return __builtin_bit_cast(unsigned, b); }
__device__ __forceinline__ u32x4 pk8(f32x4 a, f32x4 b) { u32x4 w; w.x = pk2(a[0], a[1]); w.y = pk2(a[2], a[3]); w.z = pk2(b[0], b[1]); w.w = pk2(b[2], b[3]); return w; }
__device__ __forceinline__ float bf_lo(unsigned w) { return __uint_as_float(w << 16); }
__device__ __forceinline__ float bf_hi(unsigned w) { return __uint_as_float(w & 0xffff0000u); }
__device__ __forceinline__ float sum4(f32x4 a) { return (a[0] + a[1]) + (a[2] + a[3]); }
__device__ __forceinline__ float sq4(f32x4 a) { return (a[0] * a[0] + a[1] * a[1]) + (a[2] * a[2] + a[3] * a[3]); }
__device__ __forceinline__ float swz16(float v) { return __int_as_float(__builtin_amdgcn_ds_swizzle(__float_as_int(v), 0x401F)); }
__device__ __forceinline__ float half_sum(float m) { auto rr = __builtin_amdgcn_permlane32_swap(__float_as_uint(m), __float_as_uint(m), false, false); return __uint_as_float(rr[0]) + __uint_as_float(rr[1]); }
__device__ __forceinline__ float red_fq(float s) { s += swz16(s); return half_sum(s); }
__device__ __forceinline__ float bperm(int srclane, float v) { return __int_as_float(__builtin_amdgcn_ds_bpermute(srclane << 2, __float_as_int(v))); }
__device__ __forceinline__ float sigmoidf_(float z) { return __builtin_amdgcn_rcpf(1.0f + __builtin_amdgcn_exp2f(-z * LOG2E)); }
__device__ __forceinline__ float logsigmoidf_(float z) { return fminf(z, 0.f) - __logf(1.0f + __expf(-fabsf(z))); }

template <int N4, int STRIDE> __device__ __forceinline__ void row_rstd(float (&rs)[2][4], const float* slots, int row0, float invdim, int fq) {
#pragma unroll
    for (int ai = 0; ai < 2; ++ai)
#pragma unroll
        for (int m = 0; m < 4; ++m) { const f32x4* s = (const f32x4*)(slots + (size_t)(row0 + ai * 128 + m * 16) * STRIDE);
            float t = (fq < N4) ? sum4(s[fq < N4 ? fq : 0]) : 0.f;
            t = red_fq(t);
            rs[ai][m] = rsqrtf(t * invdim + EPS); }
}
__device__ __forceinline__ void rope8(f32x4& v0, f32x4& v1, f32x4 c0, f32x4 c1, f32x4 s0, f32x4 s1, int fq) {
    f32x4 o0, o1;
#pragma unroll
    for (int j = 0; j < 4; ++j) { auto r0 = __builtin_amdgcn_permlane32_swap(__float_as_uint(v0[j]), __float_as_uint(v0[j]), false, false), r1 = __builtin_amdgcn_permlane32_swap(__float_as_uint(v1[j]), __float_as_uint(v1[j]), false, false);
        o0[j] = __uint_as_float(fq < 2 ? r0[1] : r0[0]); o1[j] = __uint_as_float(fq < 2 ? r1[1] : r1[0]); }
    const float sg = (fq < 2) ? -1.f : 1.f;
    v0 = v0 * c0 + sg * (o0 * s0); v1 = v1 * c1 + sg * (o1 * s1);
}
#define ROPE_ROWS2(ai_, mh_) f32x4 tc0[2], tc1[2], ts0[2], ts1[2]; _Pragma("unroll") for (int mm = 0; mm < 2; ++mm) { const f32x4* t_ = (const f32x4*)(rope + (size_t)((row0 + (ai_) * 128 + (2 * (mh_) + mm) * 16) & (SEQ - 1)) * 32 + 8 * (fq & 1)); tc0[mm] = t_[0]; tc1[mm] = t_[1]; ts0[mm] = t_[4]; ts1[mm] = t_[5]; }


constexpr int SPARE_OFF = 131072, SPARE_RS = SPARE_OFF, SPARE_BG = SPARE_OFF + 7168;
__device__ __forceinline__ void stage_rstd(LAS unsigned char* lds, const pg8::StaticOrder& S, const float* ssq, const float* bgate, int tid) {
    LAS float* rs = (LAS float*)(lds + SPARE_RS); LAS float* bg = (LAS float*)(lds + SPARE_BG);
    for (int e = tid; e < 7 * 256; e += 512) { const int i = e >> 8, r = e & 255; pg8::Unit u;
        if (S.next(i, u)) { const f32x4* sp = (const f32x4*)(ssq + (size_t)(u.pm * 256 + r) * 16); const f32x4 a = sp[0], b = sp[1], c = sp[2], d = sp[3];
            rs[e] = rsqrtf(((sum4(a) + sum4(b)) + (sum4(c) + sum4(d))) * (1.0f / 1024.0f) + EPS);
            if (bgate) bg[e] = (u.pn >= 12 && u.pn < 24) ? bgate[256 * (u.pn - 12) + r] : 0.f; } }
    __syncthreads();
}
__device__ __forceinline__ void row_rstd_lds(float (&rs)[2][4], const LAS float* tab, int ord, int wr, int fr) {
#pragma unroll
    for (int ai = 0; ai < 2; ++ai)
#pragma unroll
        for (int m = 0; m < 4; ++m) rs[ai][m] = tab[ord * 256 + ai * 128 + wr * 64 + m * 16 + fr];
}
typedef const pg8::f32x4 (&AccRef)[2][2][4][2];

struct EpiWin {
    static constexpr bool PERM = true, KEEP = false, INIT = false; __device__ __forceinline__ bool keep(const pg8::Unit&) const { return false; }
    const LAS float* sp; bf16 *QA, *G, *QD, *KVD, *KR; float *LF, *ssqd;
    const float *gna, *gnc, *gnr, *bgate, *bforget, *rope;
    __device__ __forceinline__ void operator()(AccRef acc, const pg8::Unit& u, int wr, int wc, int fr, int fq) const {
        const int row0 = u.pm * 256 + wr * 64 + fr; const int pn = u.pn;
        float rs[2][4]; row_rstd_lds(rs, sp, u.ord, wr, fr);
        if (pn < 12) {
            const int seg = pn >> 1, head = 4 * (pn & 1) + wc; const bool isV = (seg == 2 || seg == 5);
            bf16* out = QA + (size_t)seg * ((size_t)MTOK * 512) + head * 64 + 8 * fq;
            const float* gp = (seg < 3 ? gna : gnc) + ((seg == 1 || seg == 4) ? 64 : 0) + 8 * fq;
            const float post = (seg == 0 || seg == 3) ? QSCALE64 : 1.0f;
            f32x4 g4[2][2];
#pragma unroll
            for (int bj = 0; bj < 2; ++bj)
#pragma unroll
                for (int n = 0; n < 2; ++n) g4[bj][n] = isV ? (f32x4){1.f, 1.f, 1.f, 1.f} : *(const f32x4*)(gp + 32 * bj + 4 * n);
#pragma unroll
            for (int ai = 0; ai < 2; ++ai)
#pragma unroll
                for (int m = 0; m < 4; ++m) {
                    const float r = rs[ai][m]; f32x4 v[2][2]; float ss = 0.f;
#pragma unroll
                    for (int bj = 0; bj < 2; ++bj)
#pragma unroll
                        for (int n = 0; n < 2; ++n) { v[bj][n] = acc[ai][bj][m][n] * r; ss += sq4(v[bj][n]); }
                    float sc = 1.0f;
                    if (!isV) { ss = red_fq(ss); sc = rsqrtf(ss * (1.0f / 64.0f) + EPS) * post; }
                    bf16* rowp = out + (size_t)(row0 + ai * 128 + m * 16) * 512;
#pragma unroll
                    for (int bj = 0; bj < 2; ++bj) *(u32x4*)(rowp + 32 * bj) = pk8(v[bj][0] * sc * g4[bj][0], v[bj][1] * sc * g4[bj][1]);
                }
        } else if (pn < 24) {
            const int col0 = 256 * (pn - 12) + 32 * wc + 8 * fq;
            f32x4 b4[2][2];
#pragma unroll
            for (int bj = 0; bj < 2; ++bj)
#pragma unroll
                for (int n = 0; n < 2; ++n) b4[bj][n] = *(const LAS f32x4*)(sp + 7 * 256 + u.ord * 256 + 32 * wc + 8 * fq + 128 * bj + 4 * n);
#pragma unroll
            for (int ai = 0; ai < 2; ++ai)
#pragma unroll
                for (int m = 0; m < 4; ++m) {
                    const float r = rs[ai][m]; bf16* rowp = G + (size_t)(row0 + ai * 128 + m * 16) * 3072 + col0;
#pragma unroll
                    for (int bj = 0; bj < 2; ++bj) { f32x4 a = acc[ai][bj][m][0] * r + b4[bj][0], b = acc[ai][bj][m][1] * r + b4[bj][1];
#pragma unroll
                        for (int j = 0; j < 4; ++j) { a[j] = sigmoidf_(a[j]); b[j] = sigmoidf_(b[j]); }
                        *(u32x4*)(rowp + 128 * bj) = pk8(a, b); }
                }
        } else {
#pragma unroll
            for (int bj = 0; bj < 2; ++bj) {
                const int cb = 256 * (pn - 24) + 128 * bj + 32 * wc;
                if (cb < 640) {
                    bf16* outp = (cb < 384) ? (QD + cb + 8 * fq) : (KVD + (cb - 384) + 8 * fq); const int ld = (cb < 384) ? 384 : 256;
#pragma unroll
                    for (int ai = 0; ai < 2; ++ai)
#pragma unroll
                        for (int m = 0; m < 4; ++m) { const int row = row0 + ai * 128 + m * 16; const float r = rs[ai][m];
                            const f32x4 a = acc[ai][bj][m][0] * r, b = acc[ai][bj][m][1] * r;
                            *(u32x4*)(outp + (size_t)row * ld) = pk8(a, b);
                            const float ss = red_fq(sq4(a) + sq4(b));
                            if (fq == 0) ssqd[(size_t)row * 32 + (cb >> 5)] = ss; }
                } else if (cb == 640) {
                    const f32x4 g0 = *(const f32x4*)(gnr + 32 + 8 * fq), g1 = *(const f32x4*)(gnr + 32 + 8 * fq + 4);
#pragma unroll
                    for (int ai = 0; ai < 2; ++ai)
#pragma unroll
                    for (int mh = 0; mh < 2; ++mh) { ROPE_ROWS2(ai, mh)
#pragma unroll
                        for (int mm = 0; mm < 2; ++mm) { const int m = 2 * mh + mm; const int row = row0 + ai * 128 + m * 16; const float r = rs[ai][m];
                            f32x4 a = acc[ai][bj][m][0] * r, b = acc[ai][bj][m][1] * r;
                            const float sc = rsqrtf(red_fq(sq4(a) + sq4(b)) * (1.0f / 32.0f) + EPS);
                            a = a * sc * g0; b = b * sc * g1; rope8(a, b, tc0[mm], tc1[mm], ts0[mm], ts1[mm], fq);
                            *(u32x4*)(KR + (size_t)row * 32 + 8 * fq) = pk8(a, b); } }
                } else if (cb == 672) {
                    const f32x4 bf0 = *(const f32x4*)(bforget), bf1 = *(const f32x4*)(bforget + 4);
#pragma unroll
                    for (int ai = 0; ai < 2; ++ai)
#pragma unroll
                        for (int m = 0; m < 4; ++m) { const int row = row0 + ai * 128 + m * 16; const float r = rs[ai][m];
                            f32x4 a = acc[ai][bj][m][0] * r + bf0, b = acc[ai][bj][m][1] * r + bf1;
#pragma unroll
                            for (int j = 0; j < 4; ++j) { a[j] = logsigmoidf_(a[j]); b[j] = logsigmoidf_(b[j]); }
                            if (fq == 0) { *(f32x4*)(LF + (size_t)row * 8) = a; *(f32x4*)(LF + (size_t)row * 8 + 4) = b; } }
                }
            }
        }
    }
};

struct EpiQup {
    static constexpr bool PERM = true, KEEP = false, INIT = false; __device__ __forceinline__ bool keep(const pg8::Unit&) const { return false; }
    const float* ssqd; bf16* QB; const float *gnn, *gnr, *rope;
    __device__ __forceinline__ void operator()(AccRef acc, const pg8::Unit& u, int wr, int wc, int fr, int fq) const {
        const int row0 = u.pm * 256 + wr * 64 + fr; const int pn = u.pn;
        float rs[2][4]; row_rstd<3, 32>(rs, ssqd, row0, 1.0f / 384.0f, fq);
        if (pn < 2) {
            const int head = 4 * pn + wc; f32x4 g4[2][2];
#pragma unroll
            for (int bj = 0; bj < 2; ++bj)
#pragma unroll
                for (int n = 0; n < 2; ++n) g4[bj][n] = *(const f32x4*)(gnn + 32 * bj + 8 * fq + 4 * n);
#pragma unroll
            for (int ai = 0; ai < 2; ++ai)
#pragma unroll
                for (int m = 0; m < 4; ++m) { const float r = rs[ai][m]; f32x4 v[2][2]; float ss = 0.f;
#pragma unroll
                    for (int bj = 0; bj < 2; ++bj)
#pragma unroll
                        for (int n = 0; n < 2; ++n) { v[bj][n] = acc[ai][bj][m][n] * r; ss += sq4(v[bj][n]); }
                    const float sc = rsqrtf(red_fq(ss) * (1.0f / 64.0f) + EPS) * QSCALE96;
                    bf16* rowp = QB + (size_t)(row0 + ai * 128 + m * 16) * 768 + head * 96 + 8 * fq;
#pragma unroll
                    for (int bj = 0; bj < 2; ++bj) *(u32x4*)(rowp + 32 * bj) = pk8(v[bj][0] * sc * g4[bj][0], v[bj][1] * sc * g4[bj][1]); }
        } else {
            const f32x4 g0 = *(const f32x4*)(gnr + 8 * fq), g1 = *(const f32x4*)(gnr + 8 * fq + 4);
#pragma unroll
            for (int ai = 0; ai < 2; ++ai)
#pragma unroll
            for (int mh = 0; mh < 2; ++mh) { ROPE_ROWS2(ai, mh)
#pragma unroll
                for (int mm = 0; mm < 2; ++mm) { const int m = 2 * mh + mm; const int row = row0 + ai * 128 + m * 16; const float r = rs[ai][m];
#pragma unroll
                    for (int bj = 0; bj < 2; ++bj) { const int head = 4 * bj + wc;
                        f32x4 a = acc[ai][bj][m][0] * r, b = acc[ai][bj][m][1] * r;
                        const float sc = rsqrtf(red_fq(sq4(a) + sq4(b)) * (1.0f / 32.0f) + EPS);
                        a = a * sc * g0; b = b * sc * g1; rope8(a, b, tc0[mm], tc1[mm], ts0[mm], ts1[mm], fq);
                        *(u32x4*)(QB + (size_t)row * 768 + head * 96 + 64 + 8 * fq) = pk8(a * QSCALE96, b * QSCALE96); } } }
        }
    }
};
struct EpiKvup {
    static constexpr bool PERM = true, KEEP = false, INIT = false; __device__ __forceinline__ bool keep(const pg8::Unit&) const { return false; }
    const float* ssqd; bf16 *KBN, *VB; const float* gnn;
    __device__ __forceinline__ void operator()(AccRef acc, const pg8::Unit& u, int wr, int wc, int fr, int fq) const {
        const int row0 = u.pm * 256 + wr * 64 + fr; const int pn = u.pn;
        float rs[2][4]; row_rstd<2, 32>(rs, ssqd + 12, row0, 1.0f / 256.0f, fq);
        if (pn < 2) {
            const int head = 4 * pn + wc; f32x4 g4[2][2];
#pragma unroll
            for (int bj = 0; bj < 2; ++bj)
#pragma unroll
                for (int n = 0; n < 2; ++n) g4[bj][n] = *(const f32x4*)(gnn + 64 + 32 * bj + 8 * fq + 4 * n);
#pragma unroll
            for (int ai = 0; ai < 2; ++ai)
#pragma unroll
                for (int m = 0; m < 4; ++m) { const float r = rs[ai][m]; f32x4 v[2][2]; float ss = 0.f;
#pragma unroll
                    for (int bj = 0; bj < 2; ++bj)
#pragma unroll
                        for (int n = 0; n < 2; ++n) { v[bj][n] = acc[ai][bj][m][n] * r; ss += sq4(v[bj][n]); }
                    const float sc = rsqrtf(red_fq(ss) * (1.0f / 64.0f) + EPS);
                    bf16* rowp = KBN + (size_t)(row0 + ai * 128 + m * 16) * 512 + head * 64 + 8 * fq;
#pragma unroll
                    for (int bj = 0; bj < 2; ++bj) *(u32x4*)(rowp + 32 * bj) = pk8(v[bj][0] * sc * g4[bj][0], v[bj][1] * sc * g4[bj][1]); }
        } else {
            const int col0 = 256 * (pn - 2) + 32 * wc + 8 * fq;
#pragma unroll
            for (int ai = 0; ai < 2; ++ai)
#pragma unroll
                for (int m = 0; m < 4; ++m) { const float r = rs[ai][m]; bf16* rowp = VB + (size_t)(row0 + ai * 128 + m * 16) * 512 + col0;
#pragma unroll
                    for (int bj = 0; bj < 2; ++bj) *(u32x4*)(rowp + 128 * bj) = pk8(acc[ai][bj][m][0] * r, acc[ai][bj][m][1] * r); }
        }
    }
};
typedef pg8::f32x4 (&AccMut)[2][2][4][2];
struct EpiMerge {
    static constexpr bool PERM = true, KEEP = true, INIT = false; __device__ __forceinline__ bool keep(const pg8::Unit& u) const { return u.pz < 2; }
    const bf16* G; bf16* MG;
    __device__ __forceinline__ void operator()(AccMut acc, const pg8::Unit& u, int wr, int wc, int fr, int fq) const {
        const int row0 = u.pm * 256 + wr * 64 + fr; const int col0 = u.pn * 256 + 32 * wc + 8 * fq; const int z = u.pz;
#pragma unroll
        for (int ai = 0; ai < 2; ++ai) {
            u32x4 gn[4][2], gd[4][2];
#pragma unroll
            for (int m = 0; m < 4; ++m)
#pragma unroll
                for (int bj = 0; bj < 2; ++bj) { const bf16* gp = G + (size_t)(row0 + ai * 128 + m * 16) * 3072 + 1024 * z + col0 + 128 * bj;
                    gn[m][bj] = *(const u32x4*)gp; gd[m][bj] = (z < 2) ? *(const u32x4*)(gp + 1024) : (u32x4){0x3f803f80u, 0x3f803f80u, 0x3f803f80u, 0x3f803f80u}; }
#pragma unroll
            for (int m = 0; m < 4; ++m)
#pragma unroll
                for (int bj = 0; bj < 2; ++bj) { const u32x4 n4 = gn[m][bj], d4 = gd[m][bj];
                    f32x4 na = {bf_lo(n4.x), bf_hi(n4.x), bf_lo(n4.y), bf_hi(n4.y)}, nb = {bf_lo(n4.z), bf_hi(n4.z), bf_lo(n4.w), bf_hi(n4.w)};
                    if (z < 2) { const f32x4 da = {bf_lo(d4.x), bf_hi(d4.x), bf_lo(d4.y), bf_hi(d4.y)}, db = {bf_lo(d4.z), bf_hi(d4.z), bf_lo(d4.w), bf_hi(d4.w)};
#pragma unroll
                        for (int j = 0; j < 4; ++j) { na[j] *= __builtin_amdgcn_rcpf(fmaxf(da[j], 1e-30f)); nb[j] *= __builtin_amdgcn_rcpf(fmaxf(db[j], 1e-30f)); } }
                    const f32x4 a = acc[ai][bj][m][0] * na, b = acc[ai][bj][m][1] * nb;
                    if (z < 2) { acc[ai][bj][m][0] = a; acc[ai][bj][m][1] = b; }
                    else *(u32x4*)(MG + (size_t)(row0 + ai * 128 + m * 16) * 1024 + col0 + 128 * bj) = pk8(a, b); }
        }
    }
};
struct EpiRes {
    static constexpr bool PERM = true, KEEP = false, INIT = true; __device__ __forceinline__ bool keep(const pg8::Unit&) const { return false; }
    const float* Xin; float* X; bf16* XB; float* ssqx; int wr_xb;
    __device__ __forceinline__ void init(pg8::f32x4 (&acc)[2][2][4][2], const pg8::Unit& u, int wr, int wc, int fr, int fq) const {
        const int row0 = u.pm * 256 + wr * 64 + fr; const int col0 = u.pn * 256 + 32 * wc + 8 * fq;
#pragma unroll
        for (int ai = 0; ai < 2; ++ai)
#pragma unroll
            for (int m = 0; m < 4; ++m)
#pragma unroll
                for (int bj = 0; bj < 2; ++bj) { const float* xp = Xin + (size_t)(row0 + ai * 128 + m * 16) * 1024 + col0 + 128 * bj; acc[ai][bj][m][0] = *(const f32x4*)xp; acc[ai][bj][m][1] = *(const f32x4*)(xp + 4); }
    }
    __device__ __forceinline__ void operator()(AccRef acc, const pg8::Unit& u, int wr, int wc, int fr, int fq) const {
        const int row0 = u.pm * 256 + wr * 64 + fr; const int col0 = u.pn * 256 + 32 * wc + 8 * fq;
#pragma unroll
        for (int ai = 0; ai < 2; ++ai)
#pragma unroll
            for (int m = 0; m < 4; ++m) { const size_t row = (size_t)(row0 + ai * 128 + m * 16); float ss = 0.f;
#pragma unroll
                for (int bj = 0; bj < 2; ++bj) { float* xp = X + row * 1024 + col0 + 128 * bj;
                    const f32x4 a = acc[ai][bj][m][0], b = acc[ai][bj][m][1];
                    *(f32x4*)xp = a; *(f32x4*)(xp + 4) = b; ss += sq4(a) + sq4(b);
                    if (wr_xb) *(u32x4*)(XB + row * 1024 + col0 + 128 * bj) = pk8(a, b); }
                if (wr_xb) { ss = red_fq(ss);
                    if (fq == 0) ssqx[row * 16 + 4 * u.pn + wc] = ss; } }
    }
};
struct EpiFF1 {
    static constexpr bool PERM = true, KEEP = false, INIT = false; __device__ __forceinline__ bool keep(const pg8::Unit&) const { return false; }
    const LAS float* sp; bf16* H;
    __device__ __forceinline__ void operator()(AccRef acc, const pg8::Unit& u, int wr, int wc, int fr, int fq) const {
        const int row0 = u.pm * 256 + wr * 64 + fr; const int col0 = u.pn * 256 + 32 * wc + 8 * fq;
        float rs[2][4]; row_rstd_lds(rs, sp, u.ord, wr, fr);
#pragma unroll
        for (int ai = 0; ai < 2; ++ai)
#pragma unroll
            for (int m = 0; m < 4; ++m) { const float r = rs[ai][m]; bf16* rowp = H + (size_t)(row0 + ai * 128 + m * 16) * 4096 + col0;
#pragma unroll
                for (int bj = 0; bj < 2; ++bj) { f32x4 a = acc[ai][bj][m][0] * r, b = acc[ai][bj][m][1] * r;
#pragma unroll
                    for (int j = 0; j < 4; ++j) { a[j] = fmaxf(a[j], 0.f); b[j] = fmaxf(b[j], 0.f); }
                    *(u32x4*)(rowp + 128 * bj) = pk8(a * a, b * b); } }
    }
};
namespace att {
constexpr int KOFF = 0, KBUF = 64 * 208, VOFF = 2 * KBUF, VSTR = 192, VBUF = 64 * VSTR, KBOFF = VOFF + 2 * VBUF, RELOFF = KBOFF + 512, TKOFF = RELOFF + 2432, LDS_END = TKOFF + 16;
__device__ __forceinline__ int crow(int r, int hi) { return (r & 3) + 8 * (r >> 2) + 4 * hi; }
typedef short v4i16_t __attribute__((ext_vector_type(4)));
typedef short s16x4 __attribute__((ext_vector_type(4)));
__device__ __forceinline__ s16x4 vtr(const LAS unsigned char* p) { return __builtin_bit_cast(s16x4, __builtin_amdgcn_ds_read_tr16_b64_v4i16((LAS v4i16_t*)p)); }
__device__ __forceinline__ float hmax(float m) { auto rr = __builtin_amdgcn_permlane32_swap(__float_as_uint(m), __float_as_uint(m), false, false); return fmaxf(__uint_as_float(rr[0]), __uint_as_float(rr[1])); }
__device__ __forceinline__ float hsum(float m) { auto rr = __builtin_amdgcn_permlane32_swap(__float_as_uint(m), __float_as_uint(m), false, false); return __uint_as_float(rr[0]) + __uint_as_float(rr[1]); }

struct P { const bf16 *QA, *KA, *VA, *QB, *KBN, *KR, *VB, *QC, *KC, *VC; const float *cum, *relb; bf16 *YA, *YB, *YC; };

template <int TYPE, int ND0, int KSTR> __device__ __forceinline__ void tile(LAS unsigned char* lds, int buf, int t, int w_lo, int w_hi, int n, int qrel, int lane, int r32, int hi,
        const bf16x8 (&qr)[ND0], float& m_run, float& l_run, f32x16& o0, f32x16& o1, f32x16& negm) {
    const LAS unsigned char* kb = lds + KOFF + buf * KBUF + r32 * KSTR + hi * 16;
    bf16x8 ka[ND0], kc[ND0];
#pragma unroll
    for (int d0 = 0; d0 < ND0; ++d0) { ka[d0] = *(const LAS bf16x8*)(kb + d0 * 32); kc[d0] = *(const LAS bf16x8*)(kb + 32 * KSTR + d0 * 32); }
    const LAS unsigned char* vb = lds + VOFF + buf * VBUF + (4 * hi + ((lane & 15) >> 2)) * VSTR + (16 * ((lane >> 4) & 1) + 4 * (lane & 3)) * 2;
    s16x4 vf[4][4];
#pragma unroll
    for (int ks = 0; ks < 4; ++ks) { vf[ks][0] = vtr(vb + (16 * ks) * VSTR); vf[ks][1] = vtr(vb + (16 * ks + 8) * VSTR); vf[ks][2] = vtr(vb + (16 * ks) * VSTR + 64); vf[ks][3] = vtr(vb + (16 * ks + 8) * VSTR + 64); }
    f32x4 kbv[8];
    if (TYPE == 0) { const LAS f32x4* kbi = (const LAS f32x4*)(lds + KBOFF + buf * 256);
#pragma unroll
        for (int g = 0; g < 4; ++g) { kbv[g] = kbi[2 * g + hi]; kbv[4 + g] = kbi[8 + 2 * g + hi]; } }
    asm volatile("" ::: "memory");
    const int rel = n - t;
    f32x16 cin = negm;
    if (TYPE == 2 && rel >= 5) { const float c = ((const LAS float*)(lds + RELOFF))[512];
#pragma unroll
        for (int r = 0; r < 16; ++r) cin[r] += c; }
    f32x16 p0 = cin, p1 = cin;
#pragma unroll
    for (int d0 = 0; d0 < ND0; ++d0) {
        p0 = __builtin_amdgcn_mfma_f32_32x32x16_bf16(ka[d0], qr[d0], p0, 0, 0, 0);
        p1 = __builtin_amdgcn_mfma_f32_32x32x16_bf16(kc[d0], qr[d0], p1, 0, 0, 0);
    }
    if (TYPE == 0) {
#pragma unroll
        for (int g = 0; g < 4; ++g)
#pragma unroll
            for (int j = 0; j < 4; ++j) { p0[4 * g + j] += kbv[g][j]; p1[4 * g + j] += kbv[4 + g][j]; }
        if (t == w_hi) {
#pragma unroll
            for (int r = 0; r < 16; ++r) { const int kr_ = crow(r, hi); if (kr_ > qrel) p0[r] = -1e30f; if (kr_ + 32 > qrel) p1[r] = -1e30f; }
        }
    }
    if (TYPE == 2 && rel < 5) {
        const LAS float* rb = (const LAS float*)(lds + RELOFF) + (qrel + 64 * rel + 256 - 4 * hi - 59);
#pragma unroll
        for (int r = 0; r < 16; ++r) { p0[r] += rb[59 - ((r & 3) + 8 * (r >> 2))]; p1[r] += rb[27 - ((r & 3) + 8 * (r >> 2))]; }
    }
    if (t == w_lo) {
        float mx = fmaxf(p0[0], p1[0]);
#pragma unroll
        for (int r = 1; r < 16; ++r) mx = fmaxf(mx, fmaxf(p0[r], p1[r]));
        mx = hmax(mx); m_run = mx;
#pragma unroll
        for (int r = 0; r < 16; ++r) { p0[r] -= mx; p1[r] -= mx; negm[r] = -mx; }
    }
    float ls = 0.f;
#pragma unroll
    for (int r = 0; r < 16; ++r) { p0[r] = __builtin_amdgcn_exp2f(p0[r]); p1[r] = __builtin_amdgcn_exp2f(p1[r]); ls += p0[r] + p1[r]; }
    const float lrow = hsum(ls);
    if (__builtin_amdgcn_ballot_w64(lrow > 1048576.0f) != 0ull) {
        float pm = fmaxf(p0[0], p1[0]);
#pragma unroll
        for (int r = 1; r < 16; ++r) pm = fmaxf(pm, fmaxf(p0[r], p1[r]));
        pm = hmax(pm);
        const float dl = (lrow > 1048576.0f) ? __builtin_amdgcn_logf(pm) : 0.f;
        const float sc = __builtin_amdgcn_exp2f(-dl);
        m_run += dl; l_run *= sc; ls *= sc;
#pragma unroll
        for (int r = 0; r < 16; ++r) { p0[r] *= sc; p1[r] *= sc; o0[r] *= sc; o1[r] *= sc; negm[r] = -m_run; }
    }
    l_run += ls;
#pragma unroll
    for (int ks = 0; ks < 4; ++ks) {
        u32x4 pw;
        if (ks < 2) { pw.x = pk2(p0[8 * ks], p0[8 * ks + 1]); pw.y = pk2(p0[8 * ks + 2], p0[8 * ks + 3]); pw.z = pk2(p0[8 * ks + 4], p0[8 * ks + 5]); pw.w = pk2(p0[8 * ks + 6], p0[8 * ks + 7]); }
        else { const int k2 = ks - 2; pw.x = pk2(p1[8 * k2], p1[8 * k2 + 1]); pw.y = pk2(p1[8 * k2 + 2], p1[8 * k2 + 3]); pw.z = pk2(p1[8 * k2 + 4], p1[8 * k2 + 5]); pw.w = pk2(p1[8 * k2 + 6], p1[8 * k2 + 7]); }
        const bf16x8 pb = __builtin_bit_cast(bf16x8, pw);
        const bf16x8 va0 = __builtin_shufflevector(vf[ks][0], vf[ks][1], 0, 1, 2, 3, 4, 5, 6, 7), va1 = __builtin_shufflevector(vf[ks][2], vf[ks][3], 0, 1, 2, 3, 4, 5, 6, 7);
        o0 = __builtin_amdgcn_mfma_f32_32x32x16_bf16(va0, pb, o0, 0, 0, 0);
        o1 = __builtin_amdgcn_mfma_f32_32x32x16_bf16(va1, pb, o1, 0, 0, 0);
    }
}

template <int TYPE> __device__ __forceinline__ int unit(const P& p, LAS unsigned char* lds, int b, int h, int qb, int wave0, bool pre, unsigned nx, int G,
        u32x4& kA, u32x4& vA, u32x4& k2A, float& cbA, u32x4& kB, u32x4& vB, u32x4& k2B, float& cbB) {
    constexpr int DQK = (TYPE == 1) ? 96 : 64, ND0 = DQK / 16, KSTR = DQK * 2 + 16;
    int tid_ = wave0 * 64 + lane_id_v(); asm volatile("" : "+v"(tid_));
    const int tid = tid_, lane = tid & 63, r32 = lane & 31, hi = lane >> 5; const int w = __builtin_amdgcn_readfirstlane(tid >> 6);
    const size_t rowbase = (size_t)b * SEQ;
    const bf16* Qp = (TYPE == 0) ? p.QA : (TYPE == 1) ? p.QB : p.QC; const bf16* Kp = (TYPE == 0) ? p.KA : (TYPE == 1) ? p.KBN : p.KC; const bf16* Vp = (TYPE == 0) ? p.VA : (TYPE == 1) ? p.VB : p.VC;
    bf16* Yp = (TYPE == 0) ? p.YA : (TYPE == 1) ? p.YB : p.YC;
    constexpr int QPITCH = (TYPE == 1) ? 768 : 512;
    const int n = 4 * qb + (w >> 1);
    const int u_lo = (TYPE == 2) ? (4 * qb - 8 > 0 ? 4 * qb - 8 : 0) : 0, u_hi = 4 * qb + 3;
    const int w_lo = (TYPE == 2) ? (n - 8 > 0 ? n - 8 : 0) : 0, w_hi = n;
    bf16x8 qr[ND0];
    { const bf16* qrow = Qp + (rowbase + 256 * qb + 32 * w + r32) * QPITCH + h * DQK + 8 * hi;
#pragma unroll
      for (int d0 = 0; d0 < ND0; ++d0) qr[d0] = *(const bf16x8*)(qrow + 16 * d0); }
    if (TYPE == 2) { LAS float* rt = (LAS float*)(lds + RELOFF); for (int i = tid; i < 592; i += 512) rt[i] = p.relb[h * 513 + (i < 512 ? i : 512)] * LOG2E; }
    const int srow = tid >> 3, sch = tid & 7;
    const bf16* kg = Kp + (rowbase + srow) * 512 + h * 64 + sch * 8;
    const bf16* vg = Vp + (rowbase + srow) * 512 + h * 64 + sch * 8;
    const bf16* krg = p.KR + (rowbase + ((tid & 255) >> 2)) * 32 + (tid & 3) * 8;
    const float* cg_ = p.cum + (size_t)(b * 8 + h) * SEQ + (tid & 63);
    LAS int* tk = (LAS int*)(lds + TKOFF);
#define ATT_LOAD(t, S) do { const int tl_ = (t) < u_hi ? (t) : u_hi;     \
        k##S = *(const u32x4*)(kg + (size_t)tl_ * 64 * 512); v##S = *(const u32x4*)(vg + (size_t)tl_ * 64 * 512); \
        if (TYPE == 1) k2##S = *(const u32x4*)(krg + (size_t)tl_ * 64 * 32); if (TYPE == 0) cb##S = cg_[tl_ * 64]; } while (0)
#define ATT_LOAD_NEXT(j, S) do { k##S = *(const u32x4*)(nk + (size_t)(j) * 64 * 512); v##S = *(const u32x4*)(nv + (size_t)(j) * 64 * 512); \
        k2##S = *(const u32x4*)(nkr + (size_t)(j) * 64 * 32); cb##S = ncg[(j) * 64]; } while (0)
#define ATT_STORE(buf, S) do { *(LAS u32x4*)(lds + KOFF + (buf) * KBUF + srow * KSTR + sch * 16) = k##S; *(LAS u32x4*)(lds + VOFF + (buf) * VBUF + srow * VSTR + sch * 16) = v##S; \
        if (TYPE == 1 && tid < 256) *(LAS u32x4*)(lds + KOFF + (buf) * KBUF + (tid >> 2) * KSTR + 128 + (tid & 3) * 16) = k2##S; \
        if (TYPE == 0 && tid < 64) ((LAS float*)(lds + KBOFF + (buf) * 256))[tid] = -cb##S * LOG2E; } while (0)
    float m_run = 0.f, l_run = 0.f; f32x16 o0 = {}, o1 = {};
    f32x16 negm;
#pragma unroll
    for (int r = 0; r < 16; ++r) negm[r] = 0.f;
    if (!pre) { ATT_LOAD(u_lo, A); ATT_LOAD(u_lo + 1, B); }
    ATT_STORE(0, A);
    __syncthreads();
    const int qrel = 32 * (w & 1) + r32;
    int t = u_lo;
    for (; t < u_hi - 1; t += 2) {
        ATT_LOAD(t + 2, A);
        if (t >= w_lo && t <= w_hi) tile<TYPE, ND0, KSTR>(lds, 0, t, w_lo, w_hi, n, qrel, lane, r32, hi, qr, m_run, l_run, o0, o1, negm);
        ATT_STORE(1, B);
        __syncthreads();
        ATT_LOAD(t + 3, B);
        if (t + 1 >= w_lo && t + 1 <= w_hi) tile<TYPE, ND0, KSTR>(lds, 1, t + 1, w_lo, w_hi, n, qrel, lane, r32, hi, qr, m_run, l_run, o0, o1, negm);
        ATT_STORE(0, A);
        if (t == u_lo && tid == 0) tk[0] = G + (int)nx;
        __syncthreads();
    }
    const int inext = tk[0];
    {
        const bool nval = inext < 1536; const int ii = nval ? inext : 0;
        const int nqb = 7 - ii / 192, nrem = ii % 192, nq = nrem / 64, nbh = nrem % 64, nb = nbh >> 3, nh = nbh & 7;
        const int nT = (nq == 0) ? 1 : (nq == 1) ? 0 : 2;
        const int nlo = (nT == 2) ? (4 * nqb - 8 > 0 ? 4 * nqb - 8 : 0) : 0;
        const bf16* nKp = (nT == 0) ? p.KA : (nT == 1) ? p.KBN : p.KC; const bf16* nVp = (nT == 0) ? p.VA : (nT == 1) ? p.VB : p.VC;
        const size_t nrow = (size_t)nb * SEQ + (size_t)nlo * 64;
        const bf16* nk = nKp + (nrow + srow) * 512 + nh * 64 + sch * 8; const bf16* nv = nVp + (nrow + srow) * 512 + nh * 64 + sch * 8;
        const bf16* nkr = p.KR + (nrow + ((tid & 255) >> 2)) * 32 + (tid & 3) * 8; const float* ncg = p.cum + (size_t)(nb * 8 + nh) * SEQ + nlo * 64 + (tid & 63);
        ATT_LOAD_NEXT(0, A);
        if (t >= w_lo && t <= w_hi) tile<TYPE, ND0, KSTR>(lds, 0, t, w_lo, w_hi, n, qrel, lane, r32, hi, qr, m_run, l_run, o0, o1, negm);
        ATT_STORE(1, B);
        __syncthreads();
        ATT_LOAD_NEXT(1, B);
        if (t + 1 >= w_lo && t + 1 <= w_hi) tile<TYPE, ND0, KSTR>(lds, 1, t + 1, w_lo, w_hi, n, qrel, lane, r32, hi, qr, m_run, l_run, o0, o1, negm);
        __syncthreads();
    }
#undef ATT_LOAD
#undef ATT_LOAD_NEXT
#undef ATT_STORE
    const float inv = __builtin_amdgcn_rcpf(hsum(l_run));
    bf16* yrow = Yp + (rowbase + 256 * qb + 32 * w + r32) * 512 + h * 64 + 4 * hi;
#pragma unroll
    for (int g = 0; g < 4; ++g) {
        u32x2 w0, w1; w0.x = pk2(o0[4 * g] * inv, o0[4 * g + 1] * inv); w0.y = pk2(o0[4 * g + 2] * inv, o0[4 * g + 3] * inv);
        w1.x = pk2(o1[4 * g] * inv, o1[4 * g + 1] * inv); w1.y = pk2(o1[4 * g + 2] * inv, o1[4 * g + 3] * inv);
        *(u32x2*)(yrow + 8 * g) = w0; *(u32x2*)(yrow + 32 + 8 * g) = w1;
    }
    return inext;
}

__device__ __forceinline__ void phase(const P& p, LAS unsigned char* lds, unsigned* ctr, int wave0, int tid) {
    const int G = (int)gridDim.x;
    u32x4 kA = {}, vA = {}, k2A = {}, kB = {}, vB = {}, k2B = {}; float cbA = 0.f, cbB = 0.f;
    int i = (int)blockIdx.x; bool pre = false;
    while (i < 1536) {
        unsigned nx = 0u;
        if (tid == 0) nx = atomicAdd(ctr, 1u);
        const int qb = 7 - i / 192, rem = i % 192, ty = rem / 64, bh = rem % 64, b = bh >> 3, h = bh & 7;
        if (ty == 0) i = unit<1>(p, lds, b, h, qb, wave0, pre, nx, G, kA, vA, k2A, cbA, kB, vB, k2B, cbB);
        else if (ty == 1) i = unit<0>(p, lds, b, h, qb, wave0, pre, nx, G, kA, vA, k2A, cbA, kB, vB, k2B, cbB);
        else i = unit<2>(p, lds, b, h, qb, wave0, pre, nx, G, kA, vA, k2A, cbA, kB, vB, k2B, cbB);
        pre = true;
    }
}
}
__device__ __forceinline__ int headperm(int nseg, int pitch, int base) { const int ti = nseg >> 8, ct = nseg & 255, bj = ct >> 7, wc = (ct >> 5) & 3, j = ct & 31; return base + (4 * ti + wc) * pitch + 32 * bj + j; }
__device__ __forceinline__ int src_col(int map, int n) {
    if (map == 0) {
        if (n < 3072) { const int seg = n >> 9; const int base = seg == 0 ? 0 : seg == 1 ? 512 : seg == 2 ? 1024 : seg == 3 ? 2216 : seg == 4 ? 2728 : 3240; return headperm(n & 511, 64, base); }
        if (n < 6144) return 3752 + (n - 3072);
        const int tc = n - 6144;
        if (tc < 384) return 1544 + tc; if (tc < 640) return 1928 + (tc - 384); if (tc < 672) return 2184 + (tc - 640); if (tc < 680) return 1536 + (tc - 672); return -1;
    } else if (map == 1) {
        if (n < 512) return headperm(n, 96, 0);
        const int ct = n - 512, bj = ct >> 7, wc = (ct >> 5) & 3, j = ct & 31; return (4 * bj + wc) * 96 + 64 + j;
    } else if (map == 2) {
        if (n < 512) return headperm(n, 128, 0);
        const int c = n - 512; return (c >> 6) * 128 + 64 + (c & 63);
    }
    return n;
}
__device__ __forceinline__ void conv_item(const float* W, int K, int Nsrc, int Ndst, const float* ksc, bf16* WT, int map, int item, LAS float* scr, int lane) {
    const int nblk = Ndst / 32, kb = item / nblk, nb = item % nblk, k0 = 64 * kb, n0 = 32 * nb;
    const int sc = src_col(map, n0 + (lane & 31));
    float wv[32];
    { const float* wp = W + (size_t)(k0 + (lane >> 5)) * Nsrc + (sc >= 0 ? sc : 0);
#pragma unroll
      for (int i = 0; i < 32; ++i) wv[i] = wp[(size_t)(2 * i) * Nsrc]; }
    if (ksc) {
#pragma unroll
        for (int i = 0; i < 32; ++i) wv[i] *= ksc[k0 + 2 * i + (lane >> 5)];
    }
#pragma unroll
    for (int i = 0; i < 32; ++i) scr[(2 * i + (lane >> 5)) * 33 + (lane & 31)] = (sc >= 0) ? wv[i] : 0.f;
    asm volatile("s_waitcnt lgkmcnt(0)" ::: "memory");
    const int c = lane & 7;
#pragma unroll
    for (int j = 0; j < 4; ++j) { const int n = (lane >> 3) + 8 * j; const LAS float* s = scr + (8 * c) * 33 + n;
        u32x4 o; o.x = pk2(s[0 * 33], s[1 * 33]); o.y = pk2(s[2 * 33], s[3 * 33]); o.z = pk2(s[4 * 33], s[5 * 33]); o.w = pk2(s[6 * 33], s[7 * 33]);
        *(u32x4*)(WT + (size_t)(n0 + n) * K + k0 + 8 * c) = o; }
    asm volatile("s_waitcnt lgkmcnt(0)" ::: "memory");
}


#define XB_TMO      128
#define XB_XCNT(j)  (256  + 64 * (j))
#define XB_XSUB(j)  (1280 + 64 * (j))
#define XB_XGEN(j)  (2304 + 64 * (j))
#define XB_TOP      3328
#define XB_TOPGEN   3392
#define XCD_BAR_WORDS 3456
#define XB_SPIN_CAP (1u << 18)
__device__ __forceinline__ unsigned xb_ld(unsigned* p)              { return __hip_atomic_load(p, __ATOMIC_RELAXED, __HIP_MEMORY_SCOPE_AGENT); }
__device__ __forceinline__ unsigned xb_add(unsigned* p, unsigned v) { return __hip_atomic_fetch_add(p, v, __ATOMIC_RELAXED, __HIP_MEMORY_SCOPE_AGENT); }
__device__ __forceinline__ unsigned xb_xcc_id() { return (unsigned)__builtin_amdgcn_s_getreg((3 << 11) | 20) & 0xFu; }
#define XB_SPIN(cond, bar) do { unsigned _sp = 0; while (cond) { __builtin_amdgcn_s_sleep(1); \
    if ((++_sp & 255u) == 0u) { if (xb_ld(&(bar)[XB_TMO])) break; if (_sp > XB_SPIN_CAP) { atomicAdd(&(bar)[XB_TMO], 1u); break; } } } } while (0)
struct XcdBarrier { unsigned* bar; unsigned x; volatile LAS unsigned* st; };
__device__ __forceinline__ void xcd_barrier_complete(unsigned* bar, unsigned x, unsigned& nloc, unsigned& nx) {
    const unsigned G = gridDim.x * gridDim.y * gridDim.z;
    unsigned sum, cnt, mine, sp = 0u;
    for (;;) {
        sum = 0u; cnt = 0u; mine = 0u;
#pragma unroll
        for (unsigned j = 0; j < 16; ++j) { const unsigned c = xb_ld(&bar[XB_XCNT(j)]); sum += c; cnt += (c > 0u) ? 1u : 0u; mine = (j == x) ? c : mine; }
        if (sum == G) break;
        __builtin_amdgcn_s_sleep(1);
        if ((++sp & 255u) == 0u) { if (xb_ld(&bar[XB_TMO])) break; if (sp > XB_SPIN_CAP) { atomicAdd(&bar[XB_TMO], 1u); break; } }
    }
    nloc = mine > 0u ? mine : 1u; nx = cnt > 0u ? cnt : 1u;
}
__device__ __forceinline__ void xcd_barrier(const XcdBarrier& b, bool leader_thread) {
    asm volatile("s_waitcnt vmcnt(0)" ::: "memory");
    __syncthreads();
    if (leader_thread) {
        unsigned* bar = b.bar;
        __builtin_amdgcn_s_waitcnt(0);
        unsigned nloc = b.st[0], nx = b.st[1];
        if (nloc == 0u) { xcd_barrier_complete(bar, b.x, nloc, nx); b.st[0] = nloc; b.st[1] = nx; }
        const unsigned old = xb_add(&bar[XB_XSUB(b.x)], 1u);
        const unsigned gen = old / nloc;
        if (old + 1u == (gen + 1u) * nloc) {
            __builtin_amdgcn_fence(__ATOMIC_RELEASE, "agent");
            asm volatile("s_waitcnt vmcnt(0)" ::: "memory");
            const unsigned og = xb_add(&bar[XB_TOP], 1u);
            const unsigned tg = og / nx;
            if (og + 1u == (tg + 1u) * nx) xb_add(&bar[XB_TOPGEN], 1u);
            else XB_SPIN(xb_ld(&bar[XB_TOPGEN]) == tg, bar);
            __builtin_amdgcn_fence(__ATOMIC_ACQUIRE, "agent");
            xb_add(&bar[XB_XGEN(b.x)], 1u);
            asm volatile("s_waitcnt vmcnt(0)" ::: "memory");
        } else {
            XB_SPIN(xb_ld(&bar[XB_XGEN(b.x)]) == gen, bar);
            __builtin_amdgcn_fence(__ATOMIC_ACQUIRE, "agent");
            asm volatile("s_waitcnt vmcnt(0)" ::: "memory");
        }
    }
    __syncthreads();
}

struct Args { const float* in[19]; float* out; unsigned char* ws; int ph_lo, ph_hi; };
enum { I_X = 0, I_NMIX, I_WIN, I_BFORGET, I_BGATE, I_QKNA, I_MLAQN, I_MLAKVN, I_WQUP, I_WKVUP, I_QKNBN, I_QKNBR, I_QKNC, I_RELB, I_WBR, I_WOUT, I_NFFN, I_WFF1, I_WFF2 };
constexpr int LDS_BYTES = 147456, LDS_BARST = 147456 - 64;
constexpr size_t WS_BAR = 65536, CTL_ZERO_BYTES = 131072;

struct ConvSrc { const float *win, *nmix, *wqup, *mlaq, *wkvup, *mlakv, *wbr, *wout, *wff1, *nffn, *wff2; };
constexpr int CV_I0 = 16 * 216, CV_I1 = CV_I0 + 6 * 24, CV_I2 = CV_I1 + 4 * 32, CV_I3 = CV_I2 + 3 * 256, CV_I4 = CV_I3 + 512, CV_I5 = CV_I4 + 2048, CV_I6 = CV_I5 + 2048;
constexpr int CV_TICKETS = (CV_I6 + 7) / 8;
constexpr size_t WSET = 365 * MiB;
static_assert(WS_WIN + WSET >= WS_END, "second weight set above the activations");
__device__ __forceinline__ ConvSrc conv_src(const Args& a, int l) {
    ConvSrc c; c.win = a.in[I_WIN] + (size_t)l * 1024 * WIN_SRC; c.nmix = a.in[I_NMIX] + l * 1024; c.wqup = a.in[I_WQUP] + (size_t)l * 384 * 768; c.mlaq = a.in[I_MLAQN] + l * 384;
    c.wkvup = a.in[I_WKVUP] + (size_t)l * 256 * 1024; c.mlakv = a.in[I_MLAKVN] + l * 256; c.wbr = a.in[I_WBR] + (size_t)l * 3 * 512 * 1024; c.wout = a.in[I_WOUT] + (size_t)l * 1024 * 1024;
    c.wff1 = a.in[I_WFF1] + (size_t)l * 1024 * 4096; c.nffn = a.in[I_NFFN] + l * 1024; c.wff2 = a.in[I_WFF2] + (size_t)l * 4096 * 1024; return c;
}
__device__ __forceinline__ void conv_ticket(const ConvSrc& c, unsigned char* wd0, int ticket, LAS unsigned char* lds, int wave) {
    size_t z_ = 0; asm volatile("" : "+s"(z_)); unsigned char* wd = wd0 + z_;
    const int lane = lane_id_v(); LAS float* scr = (LAS float*)(lds + wave * 9216); const int it = 8 * ticket + wave;
    if (it < CV_I0) conv_item(c.win, 1024, WIN_SRC, WIN_N, c.nmix, (bf16*)(wd + WS_WIN), 0, it, scr, lane);
    else if (it < CV_I1) conv_item(c.wqup, 384, 768, 768, c.mlaq, (bf16*)(wd + WS_WQUP), 1, it - CV_I0, scr, lane);
    else if (it < CV_I2) conv_item(c.wkvup, 256, 1024, 1024, c.mlakv, (bf16*)(wd + WS_WKVUP), 2, it - CV_I1, scr, lane);
    else if (it < CV_I3) { const int r = it - CV_I2, z = r >> 8; conv_item(c.wbr + (size_t)z * 512 * 1024, 512, 1024, 1024, nullptr, (bf16*)(wd + WS_WBR) + (size_t)z * 1024 * 512, 3, r & 255, scr, lane); }
    else if (it < CV_I4) conv_item(c.wout, 1024, 1024, 1024, nullptr, (bf16*)(wd + WS_WOUT), 3, it - CV_I3, scr, lane);
    else if (it < CV_I5) conv_item(c.wff1, 1024, 4096, 4096, c.nffn, (bf16*)(wd + WS_WFF1), 3, it - CV_I4, scr, lane);
    else if (it < CV_I6) conv_item(c.wff2, 4096, 1024, 1024, nullptr, (bf16*)(wd + WS_WFF2), 3, it - CV_I5, scr, lane);
}

__global__ void __launch_bounds__(512, 2) fwd_kernel(Args a) {
    extern __shared__ __attribute__((aligned(16))) unsigned char lds_raw[];
    LAS unsigned char* lds = (LAS unsigned char*)lds_raw;
    cg::grid_group grid = cg::this_grid();
    const int G = gridDim.x;
    const int wave0 = __builtin_amdgcn_readfirstlane(threadIdx.x >> 6);
    const int lo = a.ph_lo, hi = a.ph_hi;
    XcdBarrier xbar; xbar.bar = (unsigned*)(a.ws + WS_BAR); xbar.x = xb_xcc_id(); xbar.st = (volatile LAS unsigned*)(lds + LDS_BARST);
    { const int t0 = wave0 * 64 + lane_id_v(); if (t0 < 2) xbar.st[t0] = 0u; __syncthreads(); if (t0 == 0) (void)xb_add(&xbar.bar[XB_XCNT(xbar.x)], 1u); }
#ifndef PROBE_DUP
#define PROBE_DUP -1
#endif
#ifndef PROBE_XSYNC
#define PROBE_XSYNC 0
#endif
#ifndef PH_MASK
#define PH_MASK 255
#endif
#define IN(k) (((PH_MASK >> ((k) & 7)) & 1) && lo <= (k) && (k) < hi)
#define SEAM(k) do { if (IN(k) && IN((k) + 1)) { if (lo < 0) grid.sync(); xcd_barrier(xbar, wave0 * 64 + lane_id_v() == 0); for (int x_ = 0; x_ < PROBE_XSYNC; ++x_) xcd_barrier(xbar, wave0 * 64 + lane_id_v() == 0); } } while (0)
#define PHASE_BEGIN size_t zo_ = 0; asm volatile("" : "+s"(zo_)); unsigned char* ws = a.ws + zo_;     int tid = wave0 * 64 + lane_id_v(); asm volatile("" : "+v"(tid)); \
    const int lane = tid & 63, wave = __builtin_amdgcn_readfirstlane(tid >> 6); (void)lane; (void)wave; \
    float* X = a.out; bf16* XB = (bf16*)(ws + WS_XB); unsigned char* wsw = ws + (size_t)(l & 1) * WSET; (void)wsw; float* ssqx = (float*)(ws + WS_SSQX); float* ssqd = (float*)(ws + WS_SSQD); float* LF = (float*)(ws + WS_LF); float* CUM = (float*)(ws + WS_CUM); float* ROPE = (float*)(ws + WS_ROPE); \
    (void)X; (void)XB; (void)ssqx; (void)ssqd; (void)LF; (void)CUM; (void)ROPE;
    for (int l = 0; l < NLAYER; ++l) {
        const int pb = 8 * l;
        for (int rep_ = 0; rep_ < ((PROBE_DUP == 0) ? 2 : 1); ++rep_) if (l == 0 && IN(pb + 0)) { if (rep_) xcd_barrier(xbar, wave0 * 64 + lane_id_v() == 0); PHASE_BEGIN
            const int gw = blockIdx.x * 8 + wave, NGW = G * 8;
            if (l == 0) {
                for (int i = blockIdx.x * 512 + tid; i < SEQ * 16; i += G * 512) { const int pos = i >> 4, k = i & 15;
                    const float inv = exp2f(-(float)k * (13.287712379549449f / 16.0f)); const float ang = (float)pos * inv;
                    const double rev = (double)ang * 0.15915494309189535; const float fr = (float)(rev - rint(rev));
                    ROPE[pos * 32 + k] = __builtin_amdgcn_cosf(fr); ROPE[pos * 32 + 16 + k] = __builtin_amdgcn_sinf(fr); }
                for (int m0 = gw; m0 < MTOK; m0 += 4 * NGW) {
                    f32x4 v[4][4];
#pragma unroll
                    for (int q = 0; q < 4; ++q) { const int m = (m0 + q * NGW < MTOK) ? m0 + q * NGW : m0; const f32x4* xr = (const f32x4*)(a.in[I_X] + (size_t)m * 1024) + lane;
#pragma unroll
                        for (int j = 0; j < 4; ++j) v[q][j] = xr[64 * j]; }
#pragma unroll
                    for (int q = 0; q < 4; ++q) { const int m = m0 + q * NGW; if (m < MTOK) { float s = 0.f;
#pragma unroll
                        for (int j = 0; j < 4; ++j) { s += sq4(v[q][j]); u32x2 o; o.x = pk2(v[q][j][0], v[q][j][1]); o.y = pk2(v[q][j][2], v[q][j][3]); ((u32x2*)(XB + (size_t)m * 1024))[lane + 64 * j] = o; }
#pragma unroll
                        for (int o = 1; o < 64; o <<= 1) s += bperm(lane ^ o, s);
                        if (lane < 16) ssqx[(size_t)m * 16 + lane] = (lane == 0) ? s : 0.f; } } }
            }
            { const ConvSrc cs = conv_src(a, 0); for (int tk_ = blockIdx.x; tk_ < CV_TICKETS; tk_ += G) conv_ticket(cs, ws, tk_, lds, wave); }
        }
        if (l == 0) SEAM(pb + 0);
        for (int rep_ = 0; rep_ < ((PROBE_DUP == 1) ? 2 : 1); ++rep_) if (IN(pb + 1)) { if (rep_) xcd_barrier(xbar, wave0 * 64 + lane_id_v() == 0); PHASE_BEGIN
            pg8::Gemm g{XB, (const bf16*)(wsw + WS_WIN), MTOK, WIN_N, 1024, 0, 0}; pg8::StaticOrder S; S.init(MTOK, WIN_N, G, (int)blockIdx.x);
            stage_rstd(lds, S, ssqx, a.in[I_BGATE] + l * 3072, tid);
            EpiWin E{(const LAS float*)(lds + SPARE_RS), (bf16*)(ws + WS_QA), (bf16*)(ws + WS_G), (bf16*)(ws + WS_QD), (bf16*)(ws + WS_KVD), (bf16*)(ws + WS_KR), LF, ssqd,
                     a.in[I_QKNA] + l * 128, a.in[I_QKNC] + l * 128, a.in[I_QKNBR] + l * 64, a.in[I_BGATE] + l * 3072, a.in[I_BFORGET] + l * 8, ROPE};
            pg8::gemm_phase<EpiWin, pg8::StaticOrder, true, true>(lds, g, S, E, wave0);
        }
        SEAM(pb + 1);
        for (int rep_ = 0; rep_ < ((PROBE_DUP == 2) ? 2 : 1); ++rep_) if (IN(pb + 2)) { if (rep_) xcd_barrier(xbar, wave0 * 64 + lane_id_v() == 0); PHASE_BEGIN
            const int sb_ = (G >= 256) ? (int)blockIdx.x - (G - 64) : (int)blockIdx.x;
            if (sb_ >= 0 && sb_ < 64 && wave == 0) { const int bh = sb_, b = bh >> 3, h = bh & 7;
                const float* lf = LF + ((size_t)b * SEQ + lane * 32) * 8 + h; float tot = 0.f;
                float lv[32];
#pragma unroll
                for (int i = 0; i < 32; ++i) lv[i] = lf[i * 8];
#pragma unroll
                for (int i = 0; i < 32; ++i) tot += lv[i];
                float inc = tot;
#pragma unroll
                for (int off = 1; off < 64; off <<= 1) { const float t = bperm(lane - off, inc); if (lane >= off) inc += t; }
                float run = inc - tot; f32x4* co = (f32x4*)(CUM + (size_t)bh * SEQ + lane * 32);
#pragma unroll
                for (int i = 0; i < 8; ++i) { f32x4 o; run += lv[4 * i]; o[0] = run; run += lv[4 * i + 1]; o[1] = run; run += lv[4 * i + 2]; o[2] = run; run += lv[4 * i + 3]; o[3] = run; co[i] = o; } }
            { pg8::Gemm g{(const bf16*)(ws + WS_QD), (const bf16*)(wsw + WS_WQUP), MTOK, 768, 384, 0, 0}; pg8::StaticOrder S; S.init(MTOK, 768, G, (int)blockIdx.x);
              EpiQup E{ssqd, (bf16*)(ws + WS_QB), a.in[I_QKNBN] + l * 128, a.in[I_QKNBR] + l * 64, ROPE};
              pg8::gemm_phase<EpiQup, pg8::StaticOrder, true, true>(lds, g, S, E, wave0); }
            { pg8::Gemm g{(const bf16*)(ws + WS_KVD), (const bf16*)(wsw + WS_WKVUP), MTOK, 1024, 256, 0, 0}; pg8::StaticOrder S; S.init(MTOK, 1024, G, (int)blockIdx.x);
              EpiKvup E{ssqd, (bf16*)(ws + WS_KBN), (bf16*)(ws + WS_VB), a.in[I_QKNBN] + l * 128};
              pg8::gemm_phase<EpiKvup, pg8::StaticOrder, true, true>(lds, g, S, E, wave0); }
            if (l + 1 < NLAYER && rep_ == 0) {
                const ConvSrc cs = conv_src(a, l + 1); unsigned char* wd = ws + (size_t)((l + 1) & 1) * WSET; unsigned* cq = (unsigned*)(ws + WS_CTL) + 16 * l + 8;
                LAS int* tkc = (LAS int*)(lds + 131072);
                int ti = (int)blockIdx.x;
                while (ti < CV_TICKETS) { unsigned nxc = 0u; if (tid == 0) nxc = atomicAdd(cq, 1u);
                    conv_ticket(cs, wd, ti, lds, wave);
                    if (tid == 0) tkc[0] = G + (int)nxc;
                    __syncthreads(); ti = tkc[0]; __syncthreads(); }
            }
        }
        SEAM(pb + 2);
        for (int rep_ = 0; rep_ < ((PROBE_DUP == 3) ? 2 : 1); ++rep_) if (IN(pb + 3)) { if (rep_) xcd_barrier(xbar, wave0 * 64 + lane_id_v() == 0); PHASE_BEGIN
            att::P p{(const bf16*)(ws + WS_QA), (const bf16*)(ws + WS_KA), (const bf16*)(ws + WS_VA), (const bf16*)(ws + WS_QB), (const bf16*)(ws + WS_KBN), (const bf16*)(ws + WS_KR), (const bf16*)(ws + WS_VB),
                     (const bf16*)(ws + WS_QC), (const bf16*)(ws + WS_KC), (const bf16*)(ws + WS_VC), CUM, a.in[I_RELB] + l * 8 * 513,
                     (bf16*)(ws + WS_Y), (bf16*)(ws + WS_Y + 16 * MiB), (bf16*)(ws + WS_Y + 32 * MiB)};
            att::phase(p, lds, (unsigned*)(ws + WS_CTL) + 16 * l + 4 * rep_, wave0, tid);
        }
        SEAM(pb + 3);
        for (int rep_ = 0; rep_ < ((PROBE_DUP == 4) ? 2 : 1); ++rep_) if (IN(pb + 4)) { if (rep_) xcd_barrier(xbar, wave0 * 64 + lane_id_v() == 0); PHASE_BEGIN
            pg8::Gemm g{(const bf16*)(ws + WS_Y), (const bf16*)(wsw + WS_WBR), MTOK, 1024, 512, (size_t)MTOK * 512 * 2, (size_t)1024 * 512 * 2}; pg8::StaticOrder S; S.init(MTOK, 1024, G, (int)blockIdx.x, 3);
            EpiMerge E{(const bf16*)(ws + WS_G), (bf16*)(ws + WS_MG)};
            pg8::gemm_phase<EpiMerge, pg8::StaticOrder, true, true>(lds, g, S, E, wave0);
        }
        SEAM(pb + 4);
        for (int rep_ = 0; rep_ < ((PROBE_DUP == 5) ? 2 : 1); ++rep_) if (IN(pb + 5)) { if (rep_) xcd_barrier(xbar, wave0 * 64 + lane_id_v() == 0); PHASE_BEGIN
            pg8::Gemm g{(const bf16*)(ws + WS_MG), (const bf16*)(wsw + WS_WOUT), MTOK, 1024, 1024, 0, 0}; pg8::StaticOrder S; S.init(MTOK, 1024, G, (int)blockIdx.x);
            EpiRes E{l == 0 ? a.in[I_X] : (const float*)X, X, XB, ssqx, 1};
            pg8::gemm_phase<EpiRes, pg8::StaticOrder, true, true>(lds, g, S, E, wave0);
        }
        SEAM(pb + 5);
        for (int rep_ = 0; rep_ < ((PROBE_DUP == 6) ? 2 : 1); ++rep_) if (IN(pb + 6)) { if (rep_) xcd_barrier(xbar, wave0 * 64 + lane_id_v() == 0); PHASE_BEGIN
            pg8::Gemm g{XB, (const bf16*)(wsw + WS_WFF1), MTOK, 4096, 1024, 0, 0}; pg8::StaticOrder S; S.init(MTOK, 4096, G, (int)blockIdx.x);
            stage_rstd(lds, S, ssqx, nullptr, tid);
            EpiFF1 E{(const LAS float*)(lds + SPARE_RS), (bf16*)(ws + WS_H)};
            pg8::gemm_phase<EpiFF1, pg8::StaticOrder, true, true>(lds, g, S, E, wave0);
        }
        SEAM(pb + 6);
        for (int rep_ = 0; rep_ < ((PROBE_DUP == 7) ? 2 : 1); ++rep_) if (IN(pb + 7)) { if (rep_) xcd_barrier(xbar, wave0 * 64 + lane_id_v() == 0); PHASE_BEGIN
            pg8::Gemm g{(const bf16*)(ws + WS_H), (const bf16*)(wsw + WS_WFF2), MTOK, 1024, 4096, 0, 0}; pg8::StaticOrder S; S.init(MTOK, 1024, G, (int)blockIdx.x);
            EpiRes E{X, X, XB, ssqx, (l + 1 < NLAYER) ? 1 : 0};
            pg8::gemm_phase<EpiRes, pg8::StaticOrder, true, true>(lds, g, S, E, wave0);
        }
        SEAM(pb + 7);
    }
#undef IN
#undef SEAM
#undef PHASE_BEGIN
}

#ifndef N_LAUNCH_MODE
#define N_LAUNCH_MODE 1
#endif
extern "C" void kernel_launch(void* const* d_in, const int* in_sizes, int n_in, void* d_out, int out_size, void* d_ws, size_t ws_size, hipStream_t stream) {
    static int grid = 0;
    if (grid == 0) {
        int dev = 0, cus = 0, per_cu = 0;
        if (n_in != 19 || out_size != MTOK * DM || ws_size < WS_WFF2 + WSET + 8 * MiB || 0) { fprintf(stderr, "kernel_launch: unexpected shapes (n_in %d out %d ws %zu)\n", n_in, out_size, ws_size); grid = -1; return; }
        (void)hipGetDevice(&dev); (void)hipDeviceGetAttribute(&cus, hipDeviceAttributeMultiprocessorCount, dev);
        (void)hipFuncSetAttribute((const void*)fwd_kernel, hipFuncAttributeMaxDynamicSharedMemorySize, LDS_BYTES);
        (void)hipOccupancyMaxActiveBlocksPerMultiprocessor(&per_cu, (const void*)fwd_kernel, 512, LDS_BYTES);
        if (per_cu < 1) per_cu = 1;
        grid = cus * per_cu;
    }
    if (grid < 0) return;
    if (hipMemsetAsync(d_ws, 0, CTL_ZERO_BYTES, stream) != hipSuccess) { fprintf(stderr, "memset failed\n"); return; }
    Args a{};
    for (int i = 0; i < 19; ++i) a.in[i] = (const float*)d_in[i];
    a.out = (float*)d_out; a.ws = (unsigned char*)d_ws;
    const int nph = 8 * NLAYER;
    for (int li = 0; li < N_LAUNCH_MODE; ++li) {
        a.ph_lo = (N_LAUNCH_MODE == 1) ? 0 : li; a.ph_hi = (N_LAUNCH_MODE == 1) ? nph : li + 1;
        void* args[] = {&a};
        hipError_t e = hipLaunchCooperativeKernel((void*)fwd_kernel, dim3(grid), dim3(512), args, LDS_BYTES, stream);
        if (e != hipSuccess) { fprintf(stderr, "cooperative launch failed: %s (grid %d)\n", hipGetErrorString(e), grid); break; }
    }
}
```
